# Optimizing an MI355X kernel written in HIP

```python
import jax
import jax.numpy as jnp
from jax import lax
import numpy as np

D_MODEL = 4096
BATCH = 2
SEQ = 4096
DEPTH = 2

CHUNK = 64
RET_HEADS = 4
RET_DK = 128
RET_DV = 256
GLA_HEADS = 4
GLA_DK = 128
GLA_DV = 256
GLA_RANK = 16
GLA_TAU = 16.0
DN_HEADS = 16
DN_DK = 128
DN_DV = 128
CONV_K = 4

ROPE_BASE = 10000.0
EPS = 1e-6
LN_EPS = 1e-5
DEEPNORM_ALPHA = float((2 * DEPTH) ** 0.25)
DEEPNORM_BETA = float((8 * DEPTH) ** -0.25)

D_MIX = RET_HEADS * RET_DV + GLA_HEADS * GLA_DV + DN_HEADS * DN_DV
DN_QKV = 2 * DN_HEADS * DN_DK + DN_HEADS * DN_DV
SPLITS = (RET_HEADS * RET_DK, RET_HEADS * RET_DK, RET_HEADS * RET_DV, RET_HEADS * RET_DV,
          GLA_HEADS * GLA_DK, GLA_HEADS * GLA_DK, GLA_HEADS * GLA_DV, GLA_HEADS * GLA_DV, GLA_RANK,
          DN_QKV, DN_HEADS * DN_DV, DN_HEADS, DN_HEADS)
SPLIT_POINTS = tuple(int(v) for v in np.cumsum(SPLITS)[:-1])
D_IN = int(sum(SPLITS))

kernel_name = 'hybrid_retention_gla_gdn_deepnorm'


def to_chunks(t):
    b, s, h, d = t.shape
    return t.reshape(b, s // CHUNK, CHUNK, h, d).transpose(1, 0, 3, 2, 4)


def from_chunks(t):
    n, b, h, c, d = t.shape
    return t.transpose(1, 0, 3, 2, 4).reshape(b, n * c, h, d)


def rotary(t, positions):
    half = t.shape[-1] // 2
    inv = ROPE_BASE ** (-jnp.arange(half, dtype=jnp.float32) / half)
    ang = positions.astype(jnp.float32)[..., None] * inv
    cos = jnp.cos(ang)[:, :, None, :]
    sin = jnp.sin(ang)[:, :, None, :]
    t1, t2 = t[..., :half], t[..., half:]
    return jnp.concatenate([t1 * cos - t2 * sin, t1 * sin + t2 * cos], axis=-1)


def head_layernorm(t):
    mu = jnp.mean(t, axis=-1, keepdims=True)
    var = jnp.mean(jnp.square(t - mu), axis=-1, keepdims=True)
    return (t - mu) * lax.rsqrt(var + EPS)


def head_rmsnorm(t):
    return t * lax.rsqrt(jnp.mean(jnp.square(t), axis=-1, keepdims=True) + EPS)


def l2norm(t):
    return t * lax.rsqrt(jnp.sum(jnp.square(t), axis=-1, keepdims=True) + EPS)


def layernorm(t, g, b):
    t = t.astype(jnp.float32)
    mu = jnp.mean(t, axis=-1, keepdims=True)
    var = jnp.mean(jnp.square(t - mu), axis=-1, keepdims=True)
    return (t - mu) * lax.rsqrt(var + LN_EPS) * g + b


def causal_depthwise_conv(u, w):
    taps, t = w.shape[0], u.shape[1]
    up = jnp.pad(u, ((0, 0), (taps - 1, 0), (0, 0)))
    out = up[:, 0:t] * w[0]
    for i in range(1, taps):
        out = out + up[:, i:i + t] * w[i]
    return out


def retention_chunkwise(q, k, v):
    b, _, h, dk = q.shape
    dv = v.shape[-1]
    log_gamma = jnp.log(1.0 - jnp.power(2.0, -5.0 - jnp.arange(h, dtype=jnp.float32)))
    i = jnp.arange(CHUNK, dtype=jnp.float32)
    diff = i[:, None] - i[None, :]
    causal = diff >= 0
    dmask = jnp.where(causal, jnp.exp(jnp.where(causal, diff, 0.0)[None] * log_gamma[:, None, None]), 0.0)
    xi = jnp.exp((i[None, :] + 1.0) * log_gamma[:, None])[..., None]
    zeta = jnp.exp((CHUNK - 1.0 - i[None, :]) * log_gamma[:, None])[..., None]
    g_chunk = jnp.exp(CHUNK * log_gamma)[:, None, None]

    def step(S, inp):
        q_c, k_c, v_c = inp
        scores = jnp.einsum('bhik,bhjk->bhij', q_c, k_c) * dmask
        o = jnp.einsum('bhij,bhjv->bhiv', scores, v_c) + jnp.einsum('bhik,bhkv->bhiv', q_c, S) * xi
        S = g_chunk * S + jnp.einsum('bhjk,bhjv->bhkv', k_c * zeta, v_c)
        return S, o

    S0 = jnp.zeros((b, h, dk, dv), jnp.float32)
    _, o = lax.scan(step, S0, (to_chunks(q), to_chunks(k), to_chunks(v)))
    return from_chunks(o)


def gla_chunkwise(q, k, v, log_a):
    b, _, h, dk = q.shape
    dv = v.shape[-1]
    causal = jnp.tril(jnp.ones((CHUNK, CHUNK), dtype=bool))

    def step(S, inp):
        q_c, k_c, v_c, a_c = inp
        b_c = jnp.cumsum(a_c, axis=2)
        b_last = b_c[:, :, -1:, :]
        diff = b_c[:, :, :, None, :] - b_c[:, :, None, :, :]
        decay = jnp.exp(jnp.where(causal[:, :, None], diff, -jnp.inf))
        scores = jnp.einsum('bhik,bhjk,bhijk->bhij', q_c, k_c, decay)
        o = jnp.einsum('bhij,bhjv->bhiv', scores, v_c) + jnp.einsum('bhik,bhkv->bhiv', q_c * jnp.exp(b_c), S)
        S = jnp.exp(b_last[:, :, 0, :])[..., None] * S + jnp.einsum('bhjk,bhjv->bhkv', k_c * jnp.exp(b_last - b_c), v_c)
        return S, o

    S0 = jnp.zeros((b, h, dk, dv), jnp.float32)
    _, o = lax.scan(step, S0, (to_chunks(q), to_chunks(k), to_chunks(v), to_chunks(log_a)))
    return from_chunks(o)


def gated_delta_chunkwise(q, k, v, beta, g):
    b, _, h, dk = q.shape
    dv = v.shape[-1]
    qc, kc, vc = to_chunks(q), to_chunks(k), to_chunks(v)
    bc = to_chunks(beta[..., None])[..., 0]
    gc = jnp.cumsum(to_chunks(g[..., None])[..., 0], axis=-1)
    lower = jnp.tril(jnp.ones((CHUNK, CHUNK), dtype=bool))
    strict = jnp.tril(jnp.ones((CHUNK, CHUNK), dtype=bool), k=-1)
    decay = jnp.exp(jnp.where(lower, gc[..., :, None] - gc[..., None, :], -jnp.inf))
    kk = jnp.einsum('nbhik,nbhjk->nbhij', kc, kc)
    a_strict = jnp.where(strict, bc[..., :, None] * kk * decay, 0.0)
    m = a_strict + jnp.eye(CHUNK, dtype=jnp.float32)
    u = lax.linalg.triangular_solve(m, vc * bc[..., None], left_side=True, lower=True, unit_diagonal=True)
    w = lax.linalg.triangular_solve(m, kc * (bc * jnp.exp(gc))[..., None], left_side=True, lower=True, unit_diagonal=True)
    qk = jnp.einsum('nbhik,nbhjk->nbhij', qc, kc) * decay

    def step(S, inp):
        q_c, k_c, u_c, w_c, g_c, qk_c = inp
        v_new = u_c - jnp.einsum('bhik,bhkv->bhiv', w_c, S)
        o = jnp.einsum('bhik,bhkv->bhiv', q_c * jnp.exp(g_c)[..., None], S) + jnp.einsum('bhij,bhjv->bhiv', qk_c, v_new)
        g_last = g_c[..., -1:]
        S = jnp.exp(g_last)[..., None] * S + jnp.einsum('bhjk,bhjv->bhkv', k_c * jnp.exp(g_last - g_c)[..., None], v_new)
        return S, o

    S0 = jnp.zeros((b, h, dk, dv), jnp.float32)
    _, o = lax.scan(step, S0, (qc, kc, u, w, gc, qk))
    return from_chunks(o)


def hybrid_layer(x, positions, w_in, gla_w_a2, gla_b_a, dn_conv_w, dn_a_log, dn_dt_bias,
                 ret_norm_g, gla_norm_g, dn_norm_g, w_out, ln_g, ln_b):
    b, s, _ = x.shape
    proj = jnp.einsum('btd,de->bte', x, w_in).astype(jnp.float32)
    (rq, rk, rv, rg, gq, gk, gv, gg, ga1, dqkv, dg, dbeta, da) = jnp.split(proj, SPLIT_POINTS, axis=-1)

    rq = rotary(rq.reshape(b, s, RET_HEADS, RET_DK), positions) * RET_DK ** -0.5
    rk = rotary(rk.reshape(b, s, RET_HEADS, RET_DK), positions)
    ro = retention_chunkwise(rq, rk, rv.reshape(b, s, RET_HEADS, RET_DV))
    ro = head_layernorm(ro) * ret_norm_g.reshape(RET_HEADS, RET_DV)
    ro = ro.reshape(b, s, -1) * jax.nn.silu(rg)

    log_a = jax.nn.log_sigmoid(jnp.einsum('btr,rk->btk', ga1, gla_w_a2) + gla_b_a) / GLA_TAU
    go = gla_chunkwise(gq.reshape(b, s, GLA_HEADS, GLA_DK) * GLA_DK ** -0.5,
                       gk.reshape(b, s, GLA_HEADS, GLA_DK),
                       gv.reshape(b, s, GLA_HEADS, GLA_DV),
                       log_a.reshape(b, s, GLA_HEADS, GLA_DK))
    go = head_rmsnorm(go) * gla_norm_g.reshape(GLA_HEADS, GLA_DV)
    go = go.reshape(b, s, -1) * jax.nn.silu(gg)

    dqkv = jax.nn.silu(causal_depthwise_conv(dqkv, dn_conv_w))
    dq, dk, dv = jnp.split(dqkv, (DN_HEADS * DN_DK, 2 * DN_HEADS * DN_DK), axis=-1)
    dq = l2norm(dq.reshape(b, s, DN_HEADS, DN_DK)) * DN_DK ** -0.5
    dk = l2norm(dk.reshape(b, s, DN_HEADS, DN_DK))
    beta = jax.nn.sigmoid(dbeta)
    g = -jnp.exp(dn_a_log.astype(jnp.float32)) * jax.nn.softplus(da + dn_dt_bias)
    do = gated_delta_chunkwise(dq, dk, dv.reshape(b, s, DN_HEADS, DN_DV), beta, g)
    do = head_rmsnorm(do) * dn_norm_g.reshape(DN_HEADS, DN_DV)
    do = do.reshape(b, s, -1) * jax.nn.silu(dg)

    mix = jnp.concatenate([ro, go, do], axis=-1).astype(x.dtype)
    y = jnp.einsum('bte,ed->btd', mix, w_out)
    return layernorm(DEEPNORM_ALPHA * x + y, ln_g, ln_b).astype(x.dtype)


def setup_inputs(seed: int = 0) -> dict:
    key = jax.random.key(seed)
    ks = jax.random.split(key, 16)
    x = jax.random.normal(ks[0], (BATCH, SEQ, D_MODEL), jnp.float32)
    positions = (jnp.arange(SEQ, dtype=jnp.int32)[None, :]
                 + jax.random.randint(ks[1], (BATCH, 1), 0, 1024, dtype=jnp.int32))
    starts = np.concatenate([[0], np.cumsum(SPLITS)]).astype(np.int64)
    col_scale = np.ones((D_IN,), np.float32)
    col_scale[starts[2]:starts[3]] = DEEPNORM_BETA
    col_scale[starts[6]:starts[7]] = DEEPNORM_BETA
    col_scale[starts[10] - DN_HEADS * DN_DV:starts[10]] = DEEPNORM_BETA
    w_in = (jax.random.normal(ks[2], (DEPTH, D_MODEL, D_IN), jnp.float32)
            * (D_MODEL ** -0.5) * jnp.asarray(col_scale))
    gla_w_a2 = jax.random.normal(ks[3], (DEPTH, GLA_RANK, GLA_HEADS * GLA_DK), jnp.float32) * GLA_RANK ** -0.5
    gla_b_a = 0.1 * jax.random.normal(ks[4], (DEPTH, GLA_HEADS * GLA_DK), jnp.float32)
    dn_conv_w = jax.random.normal(ks[5], (DEPTH, CONV_K, DN_QKV), jnp.float32) * CONV_K ** -0.5
    dn_a_log = jnp.log(jax.random.uniform(ks[6], (DEPTH, DN_HEADS), jnp.float32, 1.0, 16.0))
    dt = jnp.exp(jax.random.uniform(ks[7], (DEPTH, DN_HEADS), jnp.float32,
                                    float(np.log(1e-3)), float(np.log(1e-1))))
    dn_dt_bias = dt + jnp.log(-jnp.expm1(-dt))
    ret_norm_g = 1.0 + 0.02 * jax.random.normal(ks[8], (DEPTH, RET_HEADS * RET_DV), jnp.float32)
    gla_norm_g = 1.0 + 0.02 * jax.random.normal(ks[9], (DEPTH, GLA_HEADS * GLA_DV), jnp.float32)
    dn_norm_g = 1.0 + 0.02 * jax.random.normal(ks[10], (DEPTH, DN_HEADS * DN_DV), jnp.float32)
    w_out = (jax.random.normal(ks[11], (DEPTH, D_MIX, D_MODEL), jnp.float32)
             * (D_MIX ** -0.5) * DEEPNORM_BETA)
    ln_g = 1.0 + 0.02 * jax.random.normal(ks[12], (DEPTH, D_MODEL), jnp.float32)
    ln_b = 0.02 * jax.random.normal(ks[13], (DEPTH, D_MODEL), jnp.float32)
    return {'x': x, 'positions': positions, 'w_in': w_in, 'gla_w_a2': gla_w_a2, 'gla_b_a': gla_b_a,
            'dn_conv_w': dn_conv_w, 'dn_a_log': dn_a_log, 'dn_dt_bias': dn_dt_bias,
            'ret_norm_g': ret_norm_g, 'gla_norm_g': gla_norm_g, 'dn_norm_g': dn_norm_g,
            'w_out': w_out, 'ln_g': ln_g, 'ln_b': ln_b}


def reference(x, positions, w_in, gla_w_a2, gla_b_a, dn_conv_w, dn_a_log, dn_dt_bias,
              ret_norm_g, gla_norm_g, dn_norm_g, w_out, ln_g, ln_b):
    h = x
    for l in range(DEPTH):
        h = hybrid_layer(h, positions, w_in[l], gla_w_a2[l], gla_b_a[l], dn_conv_w[l], dn_a_log[l],
                         dn_dt_bias[l], ret_norm_g[l], gla_norm_g[l], dn_norm_g[l], w_out[l],
                         ln_g[l], ln_b[l])
    return h
```

```cpp
#include <hip/hip_runtime.h>
#include <hip/hip_cooperative_groups.h>
#include <cstdio>
namespace cg = cooperative_groups;
namespace pg8 {
#define PG8_LAS __attribute__((address_space(3)))
typedef unsigned short bf16_t;
typedef short bf16x8 __attribute__((ext_vector_type(8)));
typedef float f32x4 __attribute__((ext_vector_type(4)));
typedef unsigned u32x4 __attribute__((ext_vector_type(4)));
constexpr int BM = 256, BK = 64, HALF = 128, HTB = HALF * BK * 2  , STAGE_BYTES = 8 * HTB, NXCD = 8, WGM = 8;

__host__ __device__ __forceinline__ int lds_byte(int r, int c) { const int st = (r >> 4) * 2 + (c >> 5), rr = r & 15, cc = c & 31, ob = rr * 64 + cc * 2; return st * 1024 + (ob ^ (((ob >> 9) & 1) << 5)); }
__host__ __device__ __forceinline__ void stage_rc(int b, int& R, int& C) { const int st = b / 1024, sb = b % 1024, swz = sb ^ (((sb >> 9) & 1) << 5); R = (st >> 1) * 16 + swz / 64; C = (st & 1) * 32 + (swz % 64) / 2; }
__host__ __device__ __forceinline__ int perm32(int rho) { const int n = rho >> 4, i = rho & 15; return 8 * (i >> 2) + 4 * n + (i & 3); }

struct Unit { int pm, pn; };
struct Gemm { const bf16_t* A; const bf16_t* Bt; int M, N, K; };

struct StaticOrder {
    int nM, nN, nwg, G, c;
    __host__ __device__ void init(int M, int N, int G_, int c_) { nM = M / BM; nN = N / BM; nwg = nM * nN; G = G_; c = c_; }
    __host__ __device__ bool next(int i, Unit& u) const {
        const long L = (long)i * G + c; if (L >= nwg) return false;
        int wgid = (int)L; { const int q = nwg / NXCD, r = nwg % NXCD, xcd = wgid % NXCD, off = wgid / NXCD; wgid = (xcd < r ? xcd * (q + 1) : r * (q + 1) + (xcd - r) * q) + off; }
        const int nig = WGM * nN, gid = wgid / nig, fm = gid * WGM, gsz = (nM - fm) < WGM ? (nM - fm) : WGM;
        u.pm = fm + ((wgid % nig) % gsz); u.pn = (wgid % nig) / gsz; return true;
    }
    __device__ __forceinline__ void a_ready(const Unit&) const {}
    __device__ __forceinline__ void done(const Unit&) const {}
};
template <class Epi, class Sched, bool STAMP = false>
__device__ __forceinline__ void gemm_phase(PG8_LAS unsigned char* lds, const Gemm g, const Sched& S, const Epi& E, unsigned long long* stamps, const int tid_in) {
    const int tid = tid_in, wid = __builtin_amdgcn_readfirstlane(tid >> 6), lane = tid & 63, wr = wid >> 2, wc = wid & 3, fr = lane & 15, fq = lane >> 4;
    const int K = g.K, nt = K / BK;
    int ts_lo = 0, ts_hi = 0, nts = 0; const unsigned long long rt_entry = STAMP ? (unsigned long long)wall_clock64() : 0ull;
#define PG8_STAMP() do { if (STAMP && wid == 0 && nts < 64) { const unsigned long long _c = (unsigned long long)clock64(); \
        ts_lo = (lane == nts) ? (int)(unsigned)_c : ts_lo; ts_hi = (lane == nts) ? (int)(unsigned)(_c >> 32) : ts_hi; ++nts; } } while (0)
    PG8_STAMP();
    unsigned voffA[2], voffB[2];
#pragma unroll
    for (int i = 0; i < 2; ++i) { int R, C; stage_rc(tid * 16 + i * 8192, R, C); const int Rb = Epi::PERM ? ((R & ~31) + perm32(R & 31)) : R;
        voffA[i] = (unsigned)(R * K + C) * 2u; voffB[i] = (unsigned)(Rb * K + C) * 2u; }
    const size_t kstep = (size_t)(BK * 2);
    const size_t hstep = (size_t)HALF * K * 2;
    const size_t tstep = 2 * hstep;
    const unsigned ldsw = (unsigned)wid * 1024u;
    const int aoff = lds_byte(wr * 64 + fr, fq * 8), boff = lds_byte(wc * 32 + fr, fq * 8);
#define PG8_SA(b, h) (((b) * 2 + (h)) * HTB)
#define PG8_SB(b, h) ((4 + (b) * 2 + (h)) * HTB)
#define PG8_STAGE(bufoff, gbase, voff) do { _Pragma("unroll") for (int _i = 0; _i < 2; ++_i) \
        __builtin_amdgcn_global_load_lds((const unsigned*)((const char*)(gbase) + (voff)[_i]), (PG8_LAS unsigned*)(lds + (bufoff) + ldsw + _i * 8192), 16, 0, 0); } while (0)
#define PG8_LDA(dst, b, h) do { _Pragma("unroll") for (int m = 0; m < 4; ++m) _Pragma("unroll") for (int k = 0; k < 2; ++k) dst[m][k] = *(const PG8_LAS bf16x8*)(lds + PG8_SA(b, h) + aoff + m * 2048 + k * 1024); } while (0)
#define PG8_LDB(dst, b, h) do { _Pragma("unroll") for (int n = 0; n < 2; ++n) _Pragma("unroll") for (int k = 0; k < 2; ++k) dst[n][k] = *(const PG8_LAS bf16x8*)(lds + PG8_SB(b, h) + boff + n * 2048 + k * 1024); } while (0)
#define PG8_MMA(ai, bj, At, Bt) do { __builtin_amdgcn_s_setprio(1); _Pragma("unroll") for (int m = 0; m < 4; ++m) _Pragma("unroll") for (int n = 0; n < 2; ++n) _Pragma("unroll") for (int k = 0; k < 2; ++k) \
        acc[ai][bj][m][n] = __builtin_amdgcn_mfma_f32_16x16x32_bf16(Bt[n][k], At[m][k], acc[ai][bj][m][n], 0, 0, 0); __builtin_amdgcn_s_setprio(0); } while (0)
#define PG8_WAIT_V(n) asm volatile("s_waitcnt vmcnt(" #n ")" ::: "memory")
#define PG8_WAIT_L(n) asm volatile("s_waitcnt lgkmcnt(" #n ")" ::: "memory")
#define PG8_BAR __builtin_amdgcn_s_barrier()
#define PG8_SCHED __builtin_amdgcn_sched_barrier(0)
    Unit cur, nxt; int ui = 0;
    if (!S.next(0, cur)) return;
    f32x4 acc[2][2][4][2];
#pragma unroll
    for (int a = 0; a < 2; ++a)
#pragma unroll
        for (int b = 0; b < 2; ++b)
#pragma unroll
            for (int m = 0; m < 4; ++m)
#pragma unroll
                for (int n = 0; n < 2; ++n) acc[a][b][m][n] = (f32x4){0.f, 0.f, 0.f, 0.f};
    bf16x8 At[4][2], B0[2][2], B1[2][2];
    const char* cA = (const char*)g.A + (size_t)cur.pm * tstep; const char* cB = (const char*)g.Bt + (size_t)cur.pn * tstep;
    S.a_ready(cur);
    PG8_STAGE(PG8_SB(0, 0), cB, voffB); PG8_STAGE(PG8_SA(0, 0), cA, voffA); PG8_STAGE(PG8_SB(0, 1), cB + hstep, voffB); PG8_STAGE(PG8_SA(0, 1), cA + hstep, voffA);
    if (wr == 1) PG8_BAR;
    PG8_WAIT_V(4); PG8_BAR;
    PG8_STAGE(PG8_SB(1, 0), cB + kstep, voffB); PG8_STAGE(PG8_SA(1, 0), cA + kstep, voffA); PG8_STAGE(PG8_SB(1, 1), cB + hstep + kstep, voffB);
    PG8_WAIT_V(6); PG8_BAR;
    PG8_STAMP();
    for (;;) {
        const bool has_next = S.next(ui + 1, nxt);
        const char* nA = has_next ? (const char*)g.A + (size_t)nxt.pm * tstep : cA; const char* nB = has_next ? (const char*)g.Bt + (size_t)nxt.pn * tstep : cB;
        for (int t = 0; t < nt; t += 2) {
            const bool last = (t == nt - 2);
            const char* a1 = cA + (size_t)(t + 1) * kstep;
            const char* a2 = last ? nA : cA + (size_t)(t + 2) * kstep; const char* b2 = last ? nB : cB + (size_t)(t + 2) * kstep;
            const char* a3 = a2 + kstep; const char* b3 = b2 + kstep;
            if (last && has_next) S.a_ready(nxt);
            PG8_LDB(B0, 0, 0); PG8_SCHED; PG8_LDA(At, 0, 0); PG8_STAGE(PG8_SA(1, 1), a1 + hstep, voffA);
            PG8_WAIT_L(8); PG8_BAR; PG8_WAIT_L(0); PG8_MMA(0, 0, At, B0); PG8_BAR; PG8_SCHED;
            PG8_LDB(B1, 0, 1); PG8_STAGE(PG8_SB(0, 0), b2, voffB);
            PG8_BAR; PG8_WAIT_L(0); PG8_MMA(0, 1, At, B1); PG8_BAR;
            PG8_LDA(At, 0, 1); PG8_STAGE(PG8_SA(0, 0), a2, voffA);
            PG8_BAR; PG8_WAIT_L(0); PG8_MMA(1, 0, At, B0); PG8_BAR; PG8_SCHED;
            PG8_STAGE(PG8_SB(0, 1), b2 + hstep, voffB);
            PG8_WAIT_V(6); PG8_BAR; PG8_MMA(1, 1, At, B1); PG8_BAR;
            PG8_LDB(B0, 1, 0); PG8_SCHED; PG8_LDA(At, 1, 0); PG8_STAGE(PG8_SA(0, 1), a2 + hstep, voffA);
            PG8_WAIT_L(8); PG8_BAR; PG8_WAIT_L(0); PG8_MMA(0, 0, At, B0); PG8_BAR; PG8_SCHED;
            PG8_LDB(B1, 1, 1); PG8_STAGE(PG8_SB(1, 0), b3, voffB);
            PG8_BAR; PG8_WAIT_L(0); PG8_MMA(0, 1, At, B1); PG8_BAR;
            PG8_LDA(At, 1, 1); PG8_STAGE(PG8_SA(1, 0), a3, voffA);
            PG8_BAR; PG8_WAIT_L(0); PG8_MMA(1, 0, At, B0); PG8_BAR; PG8_SCHED;
            PG8_STAGE(PG8_SB(1, 1), b3 + hstep, voffB);
            PG8_WAIT_V(6); PG8_BAR; PG8_MMA(1, 1, At, B1); PG8_BAR;
        }
        PG8_STAMP();
        if constexpr (!Epi::AFTER_DRAIN) { E(acc, cur, wr, wc, fr, fq); S.done(cur); }
        PG8_STAMP();
        if (!has_next) break;
#pragma unroll
        for (int a = 0; a < 2; ++a)
#pragma unroll
            for (int b = 0; b < 2; ++b)
#pragma unroll
                for (int m = 0; m < 4; ++m)
#pragma unroll
                    for (int n = 0; n < 2; ++n) acc[a][b][m][n] = (f32x4){0.f, 0.f, 0.f, 0.f};
        cur = nxt; cA = nA; cB = nB; ++ui;
    }
    PG8_WAIT_V(0);
    if (wr == 0) PG8_BAR;
    PG8_BAR;
    if constexpr (Epi::AFTER_DRAIN) { E.fused(acc, cur, wr, wc, fr, fq, lds, wid, lane); S.done(cur); }
    PG8_STAMP();
    if (STAMP && wid == 0) { stamps[lane] = lane < nts ? (((unsigned long long)(unsigned)ts_hi << 32) | (unsigned)ts_lo) : 0ull;
        if (lane == 62) stamps[62] = rt_entry; if (lane == 63) stamps[63] = (unsigned long long)wall_clock64(); }
#undef PG8_STAMP
#undef PG8_SA
#undef PG8_SB
#undef PG8_STAGE
#undef PG8_LDA
#undef PG8_LDB
#undef PG8_MMA
#undef PG8_WAIT_V
#undef PG8_WAIT_L
#undef PG8_BAR
#undef PG8_SCHED
}
}

#define DI __device__ __forceinline__
#define LAS __attribute__((address_space(3)))
typedef unsigned short u16;
typedef pg8::bf16x8 bf16x8;
typedef pg8::f32x4 f32x4;
typedef pg8::u32x4 u32x4;
typedef float f32x16 __attribute__((ext_vector_type(16)));
typedef unsigned u32x2 __attribute__((ext_vector_type(2)));
typedef __bf16 bf16v2 __attribute__((ext_vector_type(2)));
typedef float f32x2 __attribute__((ext_vector_type(2)));
#define MFMA32(a, b, c) __builtin_amdgcn_mfma_f32_32x32x16_bf16((a), (b), (c), 0, 0, 0)

constexpr int TOK = 8192, SEQ = 4096, DM = 4096, NPAD = 14592, NPJ = 14336, DIN = 14384;
constexpr float ALPHA = 1.4142135623730951f;
constexpr float HEPS = 1e-6f, LNEPS = 1e-5f;
constexpr float QSCALE = 0.08838834764831845f;
constexpr size_t WS_WIN = 0;
constexpr size_t WS_WOUT = WS_WIN + (size_t)2 * NPAD * 4096 * 2;
constexpr size_t WS_XB = WS_WOUT + (size_t)2 * 4096 * 4096 * 2;
constexpr size_t WS_XF = WS_XB + (size_t)TOK * DM * 2;
constexpr size_t WS_PROJ = WS_XF + (size_t)TOK * DM * 4;
constexpr size_t WS_PROJS = WS_PROJ + (size_t)TOK * NPJ * 2;
constexpr size_t WS_QP = WS_PROJS + (size_t)TOK * 64 * 4;
constexpr size_t WS_PP = WS_QP + (size_t)3072 * 16384;
constexpr size_t WS_KT = WS_PP + (size_t)3072 * 8192;
constexpr size_t WS_WW = WS_KT + (size_t)3072 * 16384;
constexpr size_t WS_DD = WS_WW + (size_t)2048 * 16384;
constexpr size_t WS_UU = WS_DD + (size_t)3072 * 512;
constexpr size_t WS_O = WS_UU + (size_t)1024 * 32768 + (size_t)2048 * 16384;
constexpr size_t WS_MIX = WS_O + (size_t)TOK * DM * 4;
constexpr size_t WS_Z = WS_MIX + (size_t)TOK * DM * 2;
constexpr size_t WS_END = WS_Z + (size_t)TOK * DM * 4;
constexpr int LDS_BYTES = 155648;
constexpr int NPHASE = 13;

struct Args {
    const float* x; const int* pos; const float* w_in; const float* w_a2; const float* b_a; const float* conv_w; const float* a_log; const float* dt_bias;
    const float* ret_g; const float* gla_g; const float* dn_g; const float* w_out; const float* ln_g; const float* ln_b;
    float* out; unsigned char* ws; int ph_lo, ph_hi;
};

DI unsigned pk(float lo, float hi) { f32x2 v = {lo, hi}; bf16v2 r = __builtin_convertvector(v, bf16v2); return __builtin_bit_cast(unsigned, r); }
DI float bf2f(u16 v) { return __uint_as_float((unsigned)v << 16); }
DI float bflo(unsigned u) { return __uint_as_float(u << 16); }
DI float bfhi(unsigned u) { return __uint_as_float(u & 0xffff0000u); }
DI int crow(int reg, int h) { return (reg & 3) + 8 * (reg >> 2) + 4 * h; }
DI f32x16 zero16() { f32x16 z;
#pragma unroll
    for (int i = 0; i < 16; ++i) z[i] = 0.f; return z; }
DI u32x4 pack8u(const f32x16& x, const int s) { u32x4 p = {pk(x[8 * s], x[8 * s + 1]), pk(x[8 * s + 2], x[8 * s + 3]), pk(x[8 * s + 4], x[8 * s + 5]), pk(x[8 * s + 6], x[8 * s + 7])}; return p; }
DI bf16x8 pack8(const f32x16& x, const int s) { return __builtin_bit_cast(bf16x8, pack8u(x, s)); }
DI bf16x8 ld_nat(const LAS float* p) { const f32x4 a = *(const LAS f32x4*)p; const f32x4 b = *(const LAS f32x4*)(p + 4);
    u32x4 r = {pk(a[0], a[1]), pk(a[2], a[3]), pk(b[0], b[1]), pk(b[2], b[3])}; return __builtin_bit_cast(bf16x8, r); }
DI bf16x8 ld_tr(const LAS float* p, const int ld) { u32x4 r = {pk(p[0], p[ld]), pk(p[2 * ld], p[3 * ld]), pk(p[4 * ld], p[5 * ld]), pk(p[6 * ld], p[7 * ld])}; return __builtin_bit_cast(bf16x8, r); }
DI float wsum64(float v) {
#pragma unroll
    for (int o = 32; o >= 1; o >>= 1) v += __shfl_xor(v, o); return v; }
DI float wsum32(float v) {
#pragma unroll
    for (int o = 16; o >= 1; o >>= 1) v += __shfl_xor(v, o); return v; }
DI float silu(float y) { return y / (1.f + __expf(-y)); }
DI float softplus(float x) { return fmaxf(x, 0.f) + log1pf(__expf(-fabsf(x))); }

struct EpiProj {
    static constexpr bool PERM = true, AFTER_DRAIN = false;
    u16* O; float* S;
    DI void operator()(const f32x4 (&acc)[2][2][4][2], const pg8::Unit& u, int wr, int wc, int fr, int fq) const {
        const int row0 = u.pm * 256 + wr * 64 + fr;
        if (u.pn < 56) {
            const int col0 = u.pn * 256 + wc * 32 + 8 * fq;
#pragma unroll
            for (int ai = 0; ai < 2; ++ai)
#pragma unroll
                for (int m = 0; m < 4; ++m) { u16* rowp = O + (size_t)(row0 + ai * 128 + m * 16) * NPJ + col0;
#pragma unroll
                    for (int bj = 0; bj < 2; ++bj) { const f32x4 v0 = acc[ai][bj][m][0], v1 = acc[ai][bj][m][1];
                        u32x4 o = {pk(v0[0], v0[1]), pk(v0[2], v0[3]), pk(v1[0], v1[1]), pk(v1[2], v1[3])}; *(u32x4*)(rowp + bj * 128) = o; } }
        } else if (wc < 2) {
            const int col0 = wc * 32 + 8 * fq;
#pragma unroll
            for (int ai = 0; ai < 2; ++ai)
#pragma unroll
                for (int m = 0; m < 4; ++m) { float* rowp = S + (size_t)(row0 + ai * 128 + m * 16) * 64 + col0;
                    *(f32x4*)rowp = acc[ai][0][m][0]; *(f32x4*)(rowp + 4) = acc[ai][0][m][1]; }
        }
    }
};
struct EpiZ {
    static constexpr bool PERM = false, AFTER_DRAIN = false;
    float* Z; const float* X;
    DI void operator()(const f32x4 (&acc)[2][2][4][2], const pg8::Unit& u, int wr, int wc, int fr, int fq) const {
        const int row0 = u.pm * 256 + wr * 64 + fr, col0 = u.pn * 256 + wc * 32 + 4 * fq;
#pragma unroll
        for (int ai = 0; ai < 2; ++ai)
#pragma unroll
            for (int m = 0; m < 4; ++m) { const size_t ro = (size_t)(row0 + ai * 128 + m * 16) * DM + col0;
#pragma unroll
                for (int bj = 0; bj < 2; ++bj)
#pragma unroll
                    for (int n = 0; n < 2; ++n) { const f32x4 xv = *(const f32x4*)(X + ro + bj * 128 + n * 16); *(f32x4*)(Z + ro + bj * 128 + n * 16) = xv * ALPHA + acc[ai][bj][m][n]; } }
    }
};
DI int map_col(int np) { return np < 6144 ? np : (np < 14336 ? np + 16 : (np < 14352 ? np - 14336 + 6144 : (np < 14384 ? np : -1))); }
DI void phase_convert(const Args& a, LAS float* lds, const int t, const int bid) {
    u16* WIN = (u16*)(a.ws + WS_WIN); u16* WOUT = (u16*)(a.ws + WS_WOUT);
    constexpr int T_IN = 64 * 228, T_OUT = 64 * 64, T_L = T_IN + T_OUT;
    for (int tile = bid; tile < 2 * T_L; tile += gridDim.x) {
        const int l = tile / T_L; int r = tile % T_L; const float* src; u16* dst; int ldw, kt, nt; const bool isin = r < T_IN;
        if (isin) { nt = r % 228; kt = r / 228; src = a.w_in + (size_t)l * 4096 * DIN; ldw = DIN; dst = WIN + (size_t)l * NPAD * 4096; }
        else { r -= T_IN; nt = r % 64; kt = r / 64; src = a.w_out + (size_t)l * 4096 * 4096; ldw = 4096; dst = WOUT + (size_t)l * 4096 * 4096; }
        const int nl = t & 63, np = nt * 64 + nl, n = isin ? map_col(np) : np;
        float v[8];
#pragma unroll
        for (int i = 0; i < 8; ++i) { const int kl = (t >> 6) + 8 * i; v[i] = n >= 0 ? src[(size_t)(kt * 64 + kl) * ldw + n] : 0.f; }
#pragma unroll
        for (int i = 0; i < 8; ++i) { const int kl = (t >> 6) + 8 * i; lds[kl * 65 + nl] = v[i]; }
        __syncthreads();
        const int nl2 = t >> 3, kq = (t & 7) * 8; float f[8];
#pragma unroll
        for (int j = 0; j < 8; ++j) f[j] = lds[(kq + j) * 65 + nl2];
        u32x4 o = {pk(f[0], f[1]), pk(f[2], f[3]), pk(f[4], f[5]), pk(f[6], f[7])};
        *(u32x4*)(dst + (size_t)(nt * 64 + nl2) * 4096 + kt * 64 + kq) = o;
        __syncthreads();
    }
    u32x4* XB = (u32x4*)(a.ws + WS_XB); const f32x4* X4 = (const f32x4*)a.x;
    for (size_t i = (size_t)bid * 512 + t; i < (size_t)TOK * DM / 8; i += (size_t)gridDim.x * 512) {
        const f32x4 p = X4[2 * i], q = X4[2 * i + 1]; u32x4 o = {pk(p[0], p[1]), pk(p[2], p[3]), pk(q[0], q[1]), pk(q[2], q[3])}; XB[i] = o; }
}

constexpr int L_QS = 0, L_KS = 8448, L_VS = 16896, L_AS = 25344, L_TU = 29696, L_TW = 34048, L_MISC = 38400;

DI f32x16 prod_nn(const LAS float* Xa, const LAS float* Xb, int mt, int nt, int lane) {
    const int r = lane & 31, h = lane >> 5; f32x16 acc = zero16();
    const LAS float* pa = Xa + (mt * 32 + r) * 132 + 8 * h; const LAS float* pb = Xb + (nt * 32 + r) * 132 + 8 * h;
#pragma unroll
    for (int kb = 0; kb < 8; ++kb) acc = MFMA32(ld_nat(pa + 16 * kb), ld_nat(pb + 16 * kb), acc);
    return acc;
}
DI void st_acc(unsigned char* dst, const f32x16& x, int lane) { *(u32x4*)(dst + lane * 16) = pack8u(x, 0); *(u32x4*)(dst + 1024 + lane * 16) = pack8u(x, 1); }
DI void qstore(unsigned char* dst, const LAS float* X, const LAS float* rs, int t0, int nth) {
    for (int lb = t0; lb < 1024; lb += nth) { const int blk = lb >> 6, ln = lb & 63, mt = blk >> 3, st = (blk >> 1) & 3, kb = blk & 1, m = ln & 31, h = ln >> 5, i = 32 * mt + m;
        const LAS float* p = X + i * 132 + 32 * st + 16 * kb + 4 * h; const f32x4 a = *(const LAS f32x4*)p, b = *(const LAS f32x4*)(p + 8); const float s = rs ? rs[i] : 1.f;
        u32x4 o = {pk(a[0] * s, a[1] * s), pk(a[2] * s, a[3] * s), pk(b[0] * s, b[1] * s), pk(b[2] * s, b[3] * s)}; *(u32x4*)(dst + blk * 1024 + ln * 16) = o; }
}
DI void ctstore(unsigned char* dst, const LAS float* X, const LAS float* rs, int t0, int nth) {
    for (int lb = t0; lb < 1024; lb += nth) { const int blk = lb >> 6, ln = lb & 63, ct = blk >> 2, jt = (blk >> 1) & 1, kb = blk & 1, n = ln & 31, h = ln >> 5; float f[8];
#pragma unroll
        for (int jj = 0; jj < 8; ++jj) { const int j = 32 * jt + 16 * kb + 8 * (jj >> 2) + 4 * h + (jj & 3); f[jj] = X[j * 132 + 32 * ct + n] * (rs ? rs[j] : 1.f); }
        u32x4 o = {pk(f[0], f[1]), pk(f[2], f[3]), pk(f[4], f[5]), pk(f[6], f[7])}; *(u32x4*)(dst + blk * 1024 + ln * 16) = o; }
}

DI void phase_prep(const Args& a, int l, LAS float* lds, const int tid_in, const int bid) {
    LAS float* QS = lds + L_QS; LAS float* KS = lds + L_KS; LAS float* VS = lds + L_VS; LAS float* AS = lds + L_AS; LAS float* TU = lds + L_TU; LAS float* TW = lds + L_TW;
    LAS float* BETA = lds + L_MISC; LAS float* GC = lds + L_MISC + 64; LAS float* EQ = lds + L_MISC + 128; LAS float* EK = lds + L_MISC + 192;
    const u16* PROJ = (const u16*)(a.ws + WS_PROJ); const float* PROJS = (const float*)(a.ws + WS_PROJS);
    for (int g = bid; g < 3072; g += gridDim.x) {
        int t = tid_in; asm volatile("" : "+v"(t));
        const int w = __builtin_amdgcn_readfirstlane(t >> 6), lane = t & 63, r = lane & 31, h2 = lane >> 5;
        unsigned char* QPd = a.ws + WS_QP + (size_t)g * 16384; unsigned char* PPd = a.ws + WS_PP + (size_t)g * 8192; unsigned char* KTd = a.ws + WS_KT + (size_t)g * 16384;
        float* DDd = (float*)(a.ws + WS_DD + (size_t)g * 512);
        if (g < 1024) {
            const bool isret = g < 512; const int gi = isret ? g : g - 512; const int n = gi & 63, bh = gi >> 6, hh = bh & 3, b = bh >> 2; const int rowbase = b * SEQ + n * 64;
            unsigned char* UUd = a.ws + WS_UU + (size_t)g * 32768;
            int vcol0;
            if (isret) {
                vcol0 = 1024 + hh * 256;
                const int c = t & 63, seg = t >> 6;
                const float inv = exp2f(-(float)c * (13.287712379549449f / 64.f));
                const float lg2 = log2f(1.f - exp2f(-5.f - (float)hh));
#pragma unroll
                for (int ii = 0; ii < 8; ++ii) { const int i = seg * 8 + ii, row = rowbase + i;
                    const float ang = (float)a.pos[row] * inv; float rev = ang * 0.15915494309189535f; rev -= floorf(rev);
                    const float sn = __builtin_amdgcn_sinf(rev), cs = __builtin_amdgcn_cosf(rev);
                    const u16* pr = PROJ + (size_t)row * NPJ + hh * 128 + c;
                    const float q1 = bf2f(pr[0]), q2 = bf2f(pr[64]), k1 = bf2f(pr[512]), k2 = bf2f(pr[512 + 64]);
                    const float qa = q1 * cs - q2 * sn, qb = q1 * sn + q2 * cs, ka = k1 * cs - k2 * sn, kb = k1 * sn + k2 * cs;
                    const float e1 = exp2f((float)(i + 1) * lg2) , ei = exp2f(-(float)(i + 1) * lg2), ez = exp2f((float)(63 - i) * lg2);
                    QS[i * 132 + c] = qa * (QSCALE * e1); QS[i * 132 + c + 64] = qb * (QSCALE * e1);
                    KS[i * 132 + c] = ka * ei; KS[i * 132 + c + 64] = kb * ei;
                    VS[i * 132 + c] = ka * ez; VS[i * 132 + c + 64] = kb * ez; }
                if (t < 128) DDd[t] = exp2f(64.f * lg2);
            } else {
                vcol0 = 4096 + hh * 256;
                LAS float* GA = AS; LAS float* SEG = TU;
                if (t < 256) { const int row = t >> 2, part = t & 3; *(LAS f32x4*)(GA + row * 16 + part * 4) = *(const f32x4*)(PROJS + (size_t)(rowbase + row) * 64 + part * 4); }
                __syncthreads();
                const int c = t & 127, seg = t >> 7;
                float wv[16];
#pragma unroll
                for (int q = 0; q < 16; ++q) wv[q] = a.w_a2[(size_t)l * 16 * 512 + q * 512 + hh * 128 + c];
                const float bias = a.b_a[l * 512 + hh * 128 + c];
                float bl[16]; float run = 0.f;
#pragma unroll
                for (int ii = 0; ii < 16; ++ii) { const int i = seg * 16 + ii; float z = bias;
#pragma unroll
                    for (int q4 = 0; q4 < 4; ++q4) { const f32x4 gv = *(const LAS f32x4*)(GA + i * 16 + q4 * 4); z += gv[0] * wv[4 * q4] + gv[1] * wv[4 * q4 + 1] + gv[2] * wv[4 * q4 + 2] + gv[3] * wv[4 * q4 + 3]; }
                    const float ls = fminf(z, 0.f) - log1pf(__expf(-fabsf(z)));
                    run += ls * (1.f / 16.f); bl[ii] = run; }
                SEG[seg * 128 + c] = run;
                __syncthreads();
                float off = 0.f, tot = 0.f;
#pragma unroll
                for (int s = 0; s < 4; ++s) { const float sv = SEG[s * 128 + c]; tot += sv; if (s < seg) off += sv; }
#pragma unroll
                for (int ii = 0; ii < 16; ++ii) { const int i = seg * 16 + ii, row = rowbase + i; const float bi = bl[ii] + off;
                    const u16* pr = PROJ + (size_t)row * NPJ + 3072 + hh * 128 + c;
                    const float q = bf2f(pr[0]) * QSCALE, k = bf2f(pr[512]);
                    QS[i * 132 + c] = q * __expf(bi); KS[i * 132 + c] = k * __expf(-bi); VS[i * 132 + c] = k * __expf(tot - bi); }
                if (seg == 0) DDd[c] = __expf(tot);
            }
            __syncthreads();
            if (w < 4) {
                const int jt = w >> 1, it = w & 1; f32x16 acc = zero16();
                if (jt <= it) { acc = prod_nn(KS, QS, jt, it, lane);
#pragma unroll
                    for (int reg = 0; reg < 16; ++reg) { const int j = 32 * jt + crow(reg, h2), i = 32 * it + r; acc[reg] = (i >= j) ? acc[reg] : 0.f; } }
                st_acc(PPd + ((it * 2 + jt) * 2) * 1024, acc, lane);
            } else { qstore(QPd, QS, nullptr, t - 256, 256); ctstore(KTd, VS, nullptr, t - 256, 256); }
            for (int lb = t; lb < 2048; lb += 512) { const int blk = lb >> 6, ln = lb & 63, ct = blk >> 2, jt = (blk >> 1) & 1, kb = blk & 1, nn = ln & 31, hh2 = ln >> 5; unsigned f[8];
#pragma unroll
                for (int jj = 0; jj < 8; ++jj) { const int j = 32 * jt + 16 * kb + 8 * (jj >> 2) + 4 * hh2 + (jj & 3); f[jj] = PROJ[(size_t)(rowbase + j) * NPJ + vcol0 + 32 * ct + nn]; }
                u32x4 o = {f[0] | (f[1] << 16), f[2] | (f[3] << 16), f[4] | (f[5] << 16), f[6] | (f[7] << 16)}; *(u32x4*)(UUd + blk * 1024 + ln * 16) = o; }
            __syncthreads();
        } else {
            const int gi = g - 1024, n = gi & 63, bh = gi >> 6, hh = bh & 15, b = bh >> 4; const int rowbase = b * SEQ + n * 64;
            unsigned char* UUd = a.ws + WS_UU + (size_t)1024 * 32768 + (size_t)gi * 16384; unsigned char* WWd = a.ws + WS_WW + (size_t)gi * 16384;
            {
                const int c = t & 127, seg = t >> 7;
#pragma unroll
                for (int mtx = 0; mtx < 3; ++mtx) { const int ch = mtx * 2048 + hh * 128 + c; const float* cw = a.conv_w + (size_t)l * 4 * 6144 + ch;
                    const float w0 = cw[0], w1 = cw[6144], w2 = cw[2 * 6144], w3 = cw[3 * 6144];
                    const int tok0 = n * 64 + seg * 16; const u16* pc = PROJ + (size_t)(b * SEQ) * NPJ + 6144 + ch;
                    float xm3 = tok0 >= 3 ? bf2f(pc[(size_t)(tok0 - 3) * NPJ]) : 0.f, xm2 = tok0 >= 2 ? bf2f(pc[(size_t)(tok0 - 2) * NPJ]) : 0.f, xm1 = tok0 >= 1 ? bf2f(pc[(size_t)(tok0 - 1) * NPJ]) : 0.f;
                    LAS float* X = mtx == 0 ? QS : (mtx == 1 ? KS : VS);
#pragma unroll
                    for (int ii = 0; ii < 16; ++ii) { const float x0 = bf2f(pc[(size_t)(tok0 + ii) * NPJ]); const float y = w0 * xm3 + w1 * xm2 + w2 * xm1 + w3 * x0;
                        X[(seg * 16 + ii) * 132 + c] = silu(y); xm3 = xm2; xm2 = xm1; xm1 = x0; } }
            }
            if (w == 0) {
                const int row = rowbase + lane; const float bt = 1.f / (1.f + __expf(-PROJS[(size_t)row * 64 + 16 + hh]));
                float gcv = -__expf(a.a_log[l * 16 + hh]) * softplus(PROJS[(size_t)row * 64 + 32 + hh] + a.dt_bias[l * 16 + hh]);
#pragma unroll
                for (int o = 1; o < 64; o <<= 1) { const float up = __shfl_up(gcv, o); if (lane >= o) gcv += up; }
                BETA[lane] = bt; GC[lane] = gcv; const float glast = __shfl(gcv, 63); EQ[lane] = __expf(gcv); EK[lane] = __expf(glast - gcv);
                DDd[lane] = __expf(glast); DDd[lane + 64] = __expf(glast);
            }
            __syncthreads();
            {
#pragma unroll
                for (int rr = 0; rr < 8; ++rr) { const int row = w * 8 + rr;
                    float q0 = QS[row * 132 + lane], q1 = QS[row * 132 + lane + 64], k0 = KS[row * 132 + lane], k1 = KS[row * 132 + lane + 64];
                    const float sq = wsum64(q0 * q0 + q1 * q1), sk = wsum64(k0 * k0 + k1 * k1);
                    const float rq = rsqrtf(sq + HEPS) * QSCALE, rk = rsqrtf(sk + HEPS);
                    QS[row * 132 + lane] = q0 * rq; QS[row * 132 + lane + 64] = q1 * rq; KS[row * 132 + lane] = k0 * rk; KS[row * 132 + lane + 64] = k1 * rk; }
            }
            __syncthreads();
            if (w < 4) {
                const int it = w >> 1, jt = w & 1; f32x16 acc = zero16();
                if (jt <= it) { acc = prod_nn(KS, KS, it, jt, lane);
#pragma unroll
                    for (int reg = 0; reg < 16; ++reg) { const int i = 32 * it + crow(reg, h2), j = 32 * jt + r; const float dl = (i > j) ? GC[i] - GC[j] : 0.f;
                        acc[reg] = (i > j) ? acc[reg] * BETA[i] * __expf(dl) : 0.f; } }
#pragma unroll
                for (int reg = 0; reg < 16; ++reg) AS[(32 * it + crow(reg, h2)) * 68 + 32 * jt + r] = acc[reg];
            } else {
                const int jt = (w - 4) >> 1, it = (w - 4) & 1; f32x16 acc = zero16();
                if (jt <= it) { acc = prod_nn(KS, QS, jt, it, lane);
#pragma unroll
                    for (int reg = 0; reg < 16; ++reg) { const int j = 32 * jt + crow(reg, h2), i = 32 * it + r; const float dl = (i >= j) ? GC[i] - GC[j] : 0.f;
                        acc[reg] = (i >= j) ? acc[reg] * __expf(dl) : 0.f; } }
                st_acc(PPd + ((it * 2 + jt) * 2) * 1024, acc, lane);
            }
            qstore(QPd, QS, EQ, t, 512); ctstore(KTd, KS, EK, t, 512);
            __syncthreads();
            if (w == 0) {
                float Tc[64];
                const LAS float* ASo = AS; LAS float* TUo = TU + lane; LAS float* TWo = TW + lane;
                asm volatile("" : "+v"(ASo)); asm volatile("" : "+v"(TUo)); asm volatile("" : "+v"(TWo));
#pragma unroll
                for (int i = 0; i < 64; ++i) Tc[i] = 0.f;
#pragma unroll
                for (int i = 0; i < 64; ++i) { float a0 = 0.f, a1 = 0.f, a2 = 0.f, a3 = 0.f;
#pragma unroll
                    for (int j = 0; j < i; j += 4) { const f32x4 av = *(const LAS f32x4*)(ASo + i * 68 + j); a0 += av[0] * Tc[j]; a1 += av[1] * Tc[j + 1]; a2 += av[2] * Tc[j + 2]; a3 += av[3] * Tc[j + 3]; }
                    Tc[i] = ((lane == i) ? 1.f : 0.f) - ((a0 + a1) + (a2 + a3)); }
                const float bc = BETA[lane], bw = bc * EQ[lane];
#pragma unroll
                for (int i = 0; i < 64; ++i) { TUo[i * 68] = Tc[i] * bc; TWo[i * 68] = Tc[i] * bw; }
            }
            __syncthreads();
            {
                const int it = w >> 2, ct = w & 3; f32x16 au = zero16(), aw = zero16();
#pragma unroll
                for (int kb = 0; kb < 4; ++kb) {
                    au = MFMA32(ld_nat(TU + (32 * it + r) * 68 + 16 * kb + 8 * h2), ld_tr(VS + (16 * kb + 8 * h2) * 132 + 32 * ct + r, 132), au);
                    aw = MFMA32(ld_tr(KS + (16 * kb + 8 * h2) * 132 + 32 * ct + r, 132), ld_nat(TW + (32 * it + r) * 68 + 16 * kb + 8 * h2), aw); }
#pragma unroll
                for (int reg = 0; reg < 16; ++reg) aw[reg] = -aw[reg];
                st_acc(UUd + ((ct * 2 + it) * 2) * 1024, au, lane);
                st_acc(WWd + ((it * 4 + ct) * 2) * 1024, aw, lane);
            }
            __syncthreads();
        }
    }
}
DI void phase_scan(const Args& a, const int t, const int bid) {
    const int  w = t >> 6, lane = t & 63, r = lane & 31, h2 = lane >> 5;
    if (w >= 4) return;
    float* O = (float*)(a.ws + WS_O);
    for (int vb = bid; vb < 64; vb += gridDim.x) {
        int type, bh, ct, g0, colbase, b; size_t ustride; const unsigned char* UUp; const unsigned char* WWp = nullptr;
        if (vb < 32) { type = 2; bh = vb; ct = w; g0 = 1024 + bh * 64; b = bh >> 4; colbase = 2048 + (bh & 15) * 128; ustride = 16384; UUp = a.ws + WS_UU + (size_t)1024 * 32768 + (size_t)(bh * 64) * 16384; WWp = a.ws + WS_WW + (size_t)(bh * 64) * 16384; }
        else { const int v2 = vb - 32; type = v2 >> 4; bh = (v2 & 15) >> 1; ct = (v2 & 1) * 4 + w; g0 = type * 512 + bh * 64; b = bh >> 2; colbase = type * 1024 + (bh & 3) * 256; ustride = 32768; UUp = a.ws + WS_UU + (size_t)g0 * 32768; }
        const unsigned char* QPp = a.ws + WS_QP + (size_t)g0 * 16384; const unsigned char* PPp = a.ws + WS_PP + (size_t)g0 * 8192; const unsigned char* KTp = a.ws + WS_KT + (size_t)g0 * 16384;
        const unsigned char* DDp = a.ws + WS_DD + (size_t)g0 * 512;
        f32x16 S[4];
#pragma unroll
        for (int st = 0; st < 4; ++st) S[st] = zero16();
        for (int n = 0; n < 64; ++n) {
            const u32x4* up = (const u32x4*)(UUp + (size_t)n * ustride + ct * 4096 + lane * 16);
            f32x16 vn[2];
#pragma unroll
            for (int jt = 0; jt < 2; ++jt)
#pragma unroll
                for (int kb = 0; kb < 2; ++kb) { const u32x4 v = up[(jt * 2 + kb) * 64];
#pragma unroll
                    for (int q = 0; q < 4; ++q) { vn[jt][8 * kb + 2 * q] = bflo(v[q]); vn[jt][8 * kb + 2 * q + 1] = bfhi(v[q]); } }
            bf16x8 Sb[4][2];
#pragma unroll
            for (int st = 0; st < 4; ++st) { Sb[st][0] = pack8(S[st], 0); Sb[st][1] = pack8(S[st], 1); }
            if (type == 2) { const bf16x8* wp = (const bf16x8*)(WWp + (size_t)n * 16384 + lane * 16);
#pragma unroll
                for (int jt = 0; jt < 2; ++jt)
#pragma unroll
                    for (int st = 0; st < 4; ++st)
#pragma unroll
                        for (int kb = 0; kb < 2; ++kb) vn[jt] = MFMA32(wp[((jt * 4 + st) * 2 + kb) * 64], Sb[st][kb], vn[jt]); }
            f32x16 o[2]; o[0] = zero16(); o[1] = zero16();
            const bf16x8* qp = (const bf16x8*)(QPp + (size_t)n * 16384 + lane * 16);
#pragma unroll
            for (int it = 0; it < 2; ++it)
#pragma unroll
                for (int st = 0; st < 4; ++st)
#pragma unroll
                    for (int kb = 0; kb < 2; ++kb) o[it] = MFMA32(qp[((it * 4 + st) * 2 + kb) * 64], Sb[st][kb], o[it]);
            bf16x8 vbb[2][2];
#pragma unroll
            for (int jt = 0; jt < 2; ++jt) { vbb[jt][0] = pack8(vn[jt], 0); vbb[jt][1] = pack8(vn[jt], 1); }
            const bf16x8* pp = (const bf16x8*)(PPp + (size_t)n * 8192 + lane * 16);
#pragma unroll
            for (int it = 0; it < 2; ++it)
#pragma unroll
                for (int jt = 0; jt <= it; ++jt)
#pragma unroll
                    for (int kb = 0; kb < 2; ++kb) o[it] = MFMA32(pp[((it * 2 + jt) * 2 + kb) * 64], vbb[jt][kb], o[it]);
            const float* dp = (const float*)(DDp + (size_t)n * 512) + 4 * h2;
#pragma unroll
            for (int st = 0; st < 4; ++st)
#pragma unroll
                for (int gq = 0; gq < 4; ++gq) { const f32x4 dv = *(const f32x4*)(dp + 32 * st + 8 * gq);
#pragma unroll
                    for (int q = 0; q < 4; ++q) S[st][4 * gq + q] *= dv[q]; }
            const bf16x8* kp = (const bf16x8*)(KTp + (size_t)n * 16384 + lane * 16);
#pragma unroll
            for (int st = 0; st < 4; ++st)
#pragma unroll
                for (int jt = 0; jt < 2; ++jt)
#pragma unroll
                    for (int kb = 0; kb < 2; ++kb) S[st] = MFMA32(kp[((st * 2 + jt) * 2 + kb) * 64], vbb[jt][kb], S[st]);
            float* Op = O + (size_t)(b * SEQ + n * 64) * DM + colbase + 32 * ct + r;
#pragma unroll
            for (int it = 0; it < 2; ++it)
#pragma unroll
                for (int reg = 0; reg < 16; ++reg) Op[(size_t)(32 * it + crow(reg, h2)) * DM] = o[it][reg];
        }
    }
}

DI void phase_norm(const Args& a, int l, const int t, const int bid) {
    const int  w = t >> 6, lane = t & 63;
    const float* O = (const float*)(a.ws + WS_O); const u16* PROJ = (const u16*)(a.ws + WS_PROJ); u16* MIX = (u16*)(a.ws + WS_MIX);
    for (int row = bid * 8 + w; row < TOK; row += gridDim.x * 8) {
        const float* orow = O + (size_t)row * DM; const u16* prow = PROJ + (size_t)row * NPJ;
#pragma unroll 4
        for (int seg = 0; seg < 16; ++seg) {
            const int c = seg * 256 + lane * 4; f32x4 v = *(const f32x4*)(orow + c); f32x4 y; const float* gp; int gcol;
            if (seg < 4) { const float mu = wsum64(v[0] + v[1] + v[2] + v[3]) * (1.f / 256.f); v = v - mu; const float var = wsum64(v[0] * v[0] + v[1] * v[1] + v[2] * v[2] + v[3] * v[3]) * (1.f / 256.f);
                y = v * rsqrtf(var + HEPS); gp = a.ret_g + l * 1024 + c; gcol = 2048 + c; }
            else if (seg < 8) { const float ms = wsum64(v[0] * v[0] + v[1] * v[1] + v[2] * v[2] + v[3] * v[3]) * (1.f / 256.f); y = v * rsqrtf(ms + HEPS); gp = a.gla_g + l * 1024 + (c - 1024); gcol = 5120 + (c - 1024); }
            else { const float ms = wsum32(v[0] * v[0] + v[1] * v[1] + v[2] * v[2] + v[3] * v[3]) * (1.f / 128.f); y = v * rsqrtf(ms + HEPS); gp = a.dn_g + l * 2048 + (c - 2048); gcol = 12288 + (c - 2048); }
            const f32x4 gn = *(const f32x4*)gp; const u32x2 gt = *(const u32x2*)(prow + gcol);
            const float g0 = bflo(gt[0]), g1 = bfhi(gt[0]), g2 = bflo(gt[1]), g3 = bfhi(gt[1]);
            u32x2 o = {pk(y[0] * gn[0] * silu(g0), y[1] * gn[1] * silu(g1)), pk(y[2] * gn[2] * silu(g2), y[3] * gn[3] * silu(g3))};
            *(u32x2*)(MIX + (size_t)row * DM + c) = o;
        }
    }
}

DI void phase_ln(const Args& a, int l, const int t, const int bid) {
    const int  w = t >> 6, lane = t & 63;
    const float* Z = (const float*)(a.ws + WS_Z); float* XO = (l == 1) ? a.out : (float*)(a.ws + WS_XF); u16* XB = (u16*)(a.ws + WS_XB);
    const float* G = a.ln_g + l * DM; const float* Bv = a.ln_b + l * DM;
    for (int row = bid * 8 + w; row < TOK; row += gridDim.x * 8) {
        f32x4 v[16]; float s = 0.f;
#pragma unroll
        for (int q = 0; q < 16; ++q) { v[q] = *(const f32x4*)(Z + (size_t)row * DM + q * 256 + lane * 4); s += (v[q][0] + v[q][1]) + (v[q][2] + v[q][3]); }
        const float mu = wsum64(s) * (1.f / 4096.f); float s2 = 0.f;
#pragma unroll
        for (int q = 0; q < 16; ++q) { v[q] = v[q] - mu; s2 += (v[q][0] * v[q][0] + v[q][1] * v[q][1]) + (v[q][2] * v[q][2] + v[q][3] * v[q][3]); }
        const float rstd = rsqrtf(wsum64(s2) * (1.f / 4096.f) + LNEPS);
#pragma unroll
        for (int q = 0; q < 16; ++q) { const int c = q * 256 + lane * 4; const f32x4 gg = *(const f32x4*)(G + c), bb = *(const f32x4*)(Bv + c); const f32x4 y = v[q] * rstd * gg + bb;
            *(f32x4*)(XO + (size_t)row * DM + c) = y;
            if (l == 0) { u32x2 o = {pk(y[0], y[1]), pk(y[2], y[3])}; *(u32x2*)(XB + (size_t)row * DM + c) = o; } }
    }
}

__global__ void __launch_bounds__(512, 2) hybrid_fwd(Args a) {
    extern __shared__ __attribute__((aligned(16))) unsigned char smem[];
    cg::grid_group grid = cg::this_grid();
    LAS float* ldsf = (LAS float*)smem;
    for (int ph = a.ph_lo; ph < a.ph_hi; ++ph) {
        if (ph > a.ph_lo) grid.sync();
        int tid = threadIdx.x, bid = blockIdx.x; asm volatile("" : "+v"(tid)); asm volatile("" : "+s"(bid));
        if (ph == 0) {
#ifndef NO_CONV
 phase_convert(a, ldsf, tid, bid);
#endif
 continue; }
        const int l = (ph - 1) / 6, sub = (ph - 1) % 6;
        if (sub == 0) {
#ifndef NO_G1
            pg8::Gemm g; g.A = (const pg8::bf16_t*)(a.ws + WS_XB); g.Bt = (const pg8::bf16_t*)(a.ws + WS_WIN) + (size_t)l * NPAD * 4096; g.M = TOK; g.N = NPAD; g.K = 4096;
            pg8::StaticOrder so; so.init(TOK, NPAD, gridDim.x, bid);
            EpiProj e; e.O = (u16*)(a.ws + WS_PROJ); e.S = (float*)(a.ws + WS_PROJS);
            pg8::gemm_phase<EpiProj, pg8::StaticOrder, false>((LAS unsigned char*)smem, g, so, e, nullptr, tid);
            __syncthreads();
#endif
        } else if (sub == 1) {
#ifndef NO_PREP
 phase_prep(a, l, ldsf, tid, bid);
#endif
 }
        else if (sub == 2) {
#ifndef NO_SCAN
 phase_scan(a, tid, bid);
#endif
 }
        else if (sub == 3) {
#ifndef NO_NORM
 phase_norm(a, l, tid, bid);
#endif
 }
        else if (sub == 4) {
#ifndef NO_G2
            pg8::Gemm g; g.A = (const pg8::bf16_t*)(a.ws + WS_MIX); g.Bt = (const pg8::bf16_t*)(a.ws + WS_WOUT) + (size_t)l * 4096 * 4096; g.M = TOK; g.N = DM; g.K = 4096;
            pg8::StaticOrder so; so.init(TOK, DM, gridDim.x, bid);
            EpiZ e; e.Z = (float*)(a.ws + WS_Z); e.X = (l == 0) ? a.x : (const float*)(a.ws + WS_XF);
            pg8::gemm_phase<EpiZ, pg8::StaticOrder, false>((LAS unsigned char*)smem, g, so, e, nullptr, tid);
            __syncthreads();
#endif
        } else {
#ifndef NO_LN
 phase_ln(a, l, tid, bid);
#endif
 }
    }
}

extern "C" void kernel_launch(void* const* d_in, const int* in_sizes, int n_in, void* d_out, int out_size, void* d_ws, size_t ws_size, hipStream_t stream) {
    static int grid = 0;
    if (grid == 0) {
        if (n_in != 14 || ws_size < WS_END) { fprintf(stderr, "kernel_launch: unexpected inputs (n_in %d, ws %zu < %zu)\n", n_in, ws_size, (size_t)WS_END); grid = -1; return; }
        int dev = 0, cus = 0, per_cu = 0;
        hipGetDevice(&dev); hipDeviceGetAttribute(&cus, hipDeviceAttributeMultiprocessorCount, dev);
        if (hipFuncSetAttribute((const void*)hybrid_fwd, hipFuncAttributeMaxDynamicSharedMemorySize, LDS_BYTES) != hipSuccess) { fprintf(stderr, "kernel_launch: hipFuncSetAttribute failed\n"); grid = -1; return; }
        if (hipOccupancyMaxActiveBlocksPerMultiprocessor(&per_cu, (const void*)hybrid_fwd, 512, LDS_BYTES) != hipSuccess || per_cu < 1) { fprintf(stderr, "kernel_launch: occupancy query says %d\n", per_cu); per_cu = 1; }
        (void)hipGetLastError();
        grid = cus * 1;
        if (grid < 64) { fprintf(stderr, "kernel_launch: grid %d too small\n", grid); grid = -1; return; }
    }
    if (grid < 0) return;
    Args a{};
    a.x = (const float*)d_in[0]; a.pos = (const int*)d_in[1]; a.w_in = (const float*)d_in[2]; a.w_a2 = (const float*)d_in[3]; a.b_a = (const float*)d_in[4]; a.conv_w = (const float*)d_in[5];
    a.a_log = (const float*)d_in[6]; a.dt_bias = (const float*)d_in[7]; a.ret_g = (const float*)d_in[8]; a.gla_g = (const float*)d_in[9]; a.dn_g = (const float*)d_in[10];
    a.w_out = (const float*)d_in[11]; a.ln_g = (const float*)d_in[12]; a.ln_b = (const float*)d_in[13];
    a.out = (float*)d_out; a.ws = (unsigned char*)d_ws; a.ph_lo = 0; a.ph_hi = NPHASE;
    void* args[] = {&a};
    hipError_t e = hipLaunchCooperativeKernel((const void*)hybrid_fwd, dim3(grid), dim3(512), args, LDS_BYTES, stream);
    if (e != hipSuccess) fprintf(stderr, "kernel_launch: cooperative launch failed: %s (grid %d)\n", hipGetErrorString(e), grid);
}
```

```cpp
#include <hip/hip_runtime.h>
#include <hip/hip_cooperative_groups.h>
#include <cstdio>
namespace cg = cooperative_groups;
namespace pg8 {
#define PG8_LAS __attribute__((address_space(3)))
typedef unsigned short bf16_t;
typedef short bf16x8 __attribute__((ext_vector_type(8)));
typedef float f32x4 __attribute__((ext_vector_type(4)));
typedef unsigned u32x4 __attribute__((ext_vector_type(4)));
constexpr int BM = 256, BK = 64, HALF = 128, HTB = HALF * BK * 2  , STAGE_BYTES = 8 * HTB, NXCD = 8, WGM = 4;

__host__ __device__ __forceinline__ int lds_byte(int r, int c) { const int st = (r >> 4) * 2 + (c >> 5), rr = r & 15, cc = c & 31, ob = rr * 64 + cc * 2; return st * 1024 + (ob ^ (((ob >> 9) & 1) << 5)); }
__host__ __device__ __forceinline__ void stage_rc(int b, int& R, int& C) { const int st = b / 1024, sb = b % 1024, swz = sb ^ (((sb >> 9) & 1) << 5); R = (st >> 1) * 16 + swz / 64; C = (st & 1) * 32 + (swz % 64) / 2; }
__host__ __device__ __forceinline__ int perm32(int rho) { const int n = rho >> 4, i = rho & 15; return 8 * (i >> 2) + 4 * n + (i & 3); }

struct Unit { int pm, pn; };
struct Gemm { const bf16_t* A; const bf16_t* Bt; int M, N, K; };

struct StaticOrder {
    int nM, nN, nwg, G, c;
    __host__ __device__ void init(int M, int N, int G_, int c_) { nM = M / BM; nN = N / BM; nwg = nM * nN; G = G_; c = c_; }
    __host__ __device__ bool next(int i, Unit& u) const {
        const long L = (long)i * G + c; if (L >= nwg) return false;
        int wgid = (int)L; { const int q = nwg / NXCD, r = nwg % NXCD, xcd = wgid % NXCD, off = wgid / NXCD; wgid = (xcd < r ? xcd * (q + 1) : r * (q + 1) + (xcd - r) * q) + off; }
        const int nig = WGM * nN, gid = wgid / nig, fm = gid * WGM, gsz = (nM - fm) < WGM ? (nM - fm) : WGM;
        u.pm = fm + ((wgid % nig) % gsz); u.pn = (wgid % nig) / gsz; return true;
    }
    __device__ __forceinline__ void a_ready(const Unit&) const {}
    __device__ __forceinline__ void done(const Unit&) const {}
};
template <class Epi, class Sched, bool STAMP = false>
__device__ __forceinline__ void gemm_phase(PG8_LAS unsigned char* lds, const Gemm g, const Sched& S, const Epi& E, unsigned long long* stamps, const int tid_in) {
    const int tid = tid_in, wid = __builtin_amdgcn_readfirstlane(tid >> 6), lane = tid & 63, wr = wid >> 2, wc = wid & 3, fr = lane & 15, fq = lane >> 4;
    const int K = g.K, nt = K / BK;
    int ts_lo = 0, ts_hi = 0, nts = 0; const unsigned long long rt_entry = STAMP ? (unsigned long long)wall_clock64() : 0ull;
#define PG8_STAMP() do { if (STAMP && wid == 0 && nts < 64) { const unsigned long long _c = (unsigned long long)clock64(); \
        ts_lo = (lane == nts) ? (int)(unsigned)_c : ts_lo; ts_hi = (lane == nts) ? (int)(unsigned)(_c >> 32) : ts_hi; ++nts; } } while (0)
    PG8_STAMP();
    unsigned voffA[2], voffB[2];
#pragma unroll
    for (int i = 0; i < 2; ++i) { int R, C; stage_rc(tid * 16 + i * 8192, R, C); const int Rb = Epi::PERM ? ((R & ~31) + perm32(R & 31)) : R;
        voffA[i] = (unsigned)(R * K + C) * 2u; voffB[i] = (unsigned)(Rb * K + C) * 2u; }
    const size_t kstep = (size_t)(BK * 2);
    const size_t hstep = (size_t)HALF * K * 2;
    const size_t tstep = 2 * hstep;
    const unsigned ldsw = (unsigned)wid * 1024u;
    const int aoff = lds_byte(wr * 64 + fr, fq * 8), boff = lds_byte(wc * 32 + fr, fq * 8);
#define PG8_SA(b, h) (((b) * 2 + (h)) * HTB)
#define PG8_SB(b, h) ((4 + (b) * 2 + (h)) * HTB)
#define PG8_STAGE(bufoff, gbase, voff) do { _Pragma("unroll") for (int _i = 0; _i < 2; ++_i) \
        __builtin_amdgcn_global_load_lds((const unsigned*)((const char*)(gbase) + (voff)[_i]), (PG8_LAS unsigned*)(lds + (bufoff) + ldsw + _i * 8192), 16, 0, 0); } while (0)
#define PG8_LDA(dst, b, h) do { _Pragma("unroll") for (int m = 0; m < 4; ++m) _Pragma("unroll") for (int k = 0; k < 2; ++k) dst[m][k] = *(const PG8_LAS bf16x8*)(lds + PG8_SA(b, h) + aoff + m * 2048 + k * 1024); } while (0)
#define PG8_LDB(dst, b, h) do { _Pragma("unroll") for (int n = 0; n < 2; ++n) _Pragma("unroll") for (int k = 0; k < 2; ++k) dst[n][k] = *(const PG8_LAS bf16x8*)(lds + PG8_SB(b, h) + boff + n * 2048 + k * 1024); } while (0)
#define PG8_MMA(ai, bj, At, Bt) do { __builtin_amdgcn_s_setprio(1); _Pragma("unroll") for (int m = 0; m < 4; ++m) _Pragma("unroll") for (int n = 0; n < 2; ++n) _Pragma("unroll") for (int k = 0; k < 2; ++k) \
        acc[ai][bj][m][n] = __builtin_amdgcn_mfma_f32_16x16x32_bf16(Bt[n][k], At[m][k], acc[ai][bj][m][n], 0, 0, 0); __builtin_amdgcn_s_setprio(0); } while (0)
#define PG8_WAIT_V(n) asm volatile("s_waitcnt vmcnt(" #n ")" ::: "memory")
#define PG8_WAIT_L(n) asm volatile("s_waitcnt lgkmcnt(" #n ")" ::: "memory")
#define PG8_BAR __builtin_amdgcn_s_barrier()
#define PG8_SCHED __builtin_amdgcn_sched_barrier(0)
    Unit cur, nxt; int ui = 0;
    if (!S.next(0, cur)) return;
    f32x4 acc[2][2][4][2];
#pragma unroll
    for (int a = 0; a < 2; ++a)
#pragma unroll
        for (int b = 0; b < 2; ++b)
#pragma unroll
            for (int m = 0; m < 4; ++m)
#pragma unroll
                for (int n = 0; n < 2; ++n) acc[a][b][m][n] = (f32x4){0.f, 0.f, 0.f, 0.f};
    bf16x8 At[4][2], B0[2][2], B1[2][2];
    const char* cA = (const char*)g.A + (size_t)cur.pm * tstep; const char* cB = (const char*)g.Bt + (size_t)cur.pn * tstep;
    S.a_ready(cur);
    PG8_STAGE(PG8_SB(0, 0), cB, voffB); PG8_STAGE(PG8_SA(0, 0), cA, voffA); PG8_STAGE(PG8_SB(0, 1), cB + hstep, voffB); PG8_STAGE(PG8_SA(0, 1), cA + hstep, voffA);
    if (wr == 1) PG8_BAR;
    PG8_WAIT_V(4); PG8_BAR;
    PG8_STAGE(PG8_SB(1, 0), cB + kstep, voffB); PG8_STAGE(PG8_SA(1, 0), cA + kstep, voffA); PG8_STAGE(PG8_SB(1, 1), cB + hstep + kstep, voffB);
    PG8_WAIT_V(6); PG8_BAR;
    PG8_STAMP();
    for (;;) {
        const bool has_next = S.next(ui + 1, nxt);
        const char* nA = has_next ? (const char*)g.A + (size_t)nxt.pm * tstep : cA; const char* nB = has_next ? (const char*)g.Bt + (size_t)nxt.pn * tstep : cB;
        for (int t = 0; t < nt; t += 2) {
            const bool last = (t == nt - 2);
            const char* a1 = cA + (size_t)(t + 1) * kstep;
            const char* a2 = last ? nA : cA + (size_t)(t + 2) * kstep; const char* b2 = last ? nB : cB + (size_t)(t + 2) * kstep;
            const char* a3 = a2 + kstep; const char* b3 = b2 + kstep;
            if (last && has_next) S.a_ready(nxt);
            PG8_LDB(B0, 0, 0); PG8_SCHED; PG8_LDA(At, 0, 0); PG8_STAGE(PG8_SA(1, 1), a1 + hstep, voffA);
            PG8_WAIT_L(8); PG8_BAR; PG8_WAIT_L(0); PG8_MMA(0, 0, At, B0); PG8_BAR; PG8_SCHED;
            PG8_LDB(B1, 0, 1); PG8_STAGE(PG8_SB(0, 0), b2, voffB);
            PG8_BAR; PG8_WAIT_L(0); PG8_MMA(0, 1, At, B1); PG8_BAR;
            PG8_LDA(At, 0, 1); PG8_STAGE(PG8_SA(0, 0), a2, voffA);
            PG8_BAR; PG8_WAIT_L(0); PG8_MMA(1, 0, At, B0); PG8_BAR; PG8_SCHED;
            PG8_STAGE(PG8_SB(0, 1), b2 + hstep, voffB);
            PG8_WAIT_V(6); PG8_BAR; PG8_MMA(1, 1, At, B1); PG8_BAR;
            PG8_LDB(B0, 1, 0); PG8_SCHED; PG8_LDA(At, 1, 0); PG8_STAGE(PG8_SA(0, 1), a2 + hstep, voffA);
            PG8_WAIT_L(8); PG8_BAR; PG8_WAIT_L(0); PG8_MMA(0, 0, At, B0); PG8_BAR; PG8_SCHED;
            PG8_LDB(B1, 1, 1); PG8_STAGE(PG8_SB(1, 0), b3, voffB);
            PG8_BAR; PG8_WAIT_L(0); PG8_MMA(0, 1, At, B1); PG8_BAR;
            PG8_LDA(At, 1, 1); PG8_STAGE(PG8_SA(1, 0), a3, voffA);
            PG8_BAR; PG8_WAIT_L(0); PG8_MMA(1, 0, At, B0); PG8_BAR; PG8_SCHED;
            PG8_STAGE(PG8_SB(1, 1), b3 + hstep, voffB);
            PG8_WAIT_V(6); PG8_BAR; PG8_MMA(1, 1, At, B1); PG8_BAR;
        }
        PG8_STAMP();
        if constexpr (!Epi::AFTER_DRAIN) { E(acc, cur, wr, wc, fr, fq); S.done(cur); }
        PG8_STAMP();
        if (!has_next) break;
#pragma unroll
        for (int a = 0; a < 2; ++a)
#pragma unroll
            for (int b = 0; b < 2; ++b)
#pragma unroll
                for (int m = 0; m < 4; ++m)
#pragma unroll
                    for (int n = 0; n < 2; ++n) acc[a][b][m][n] = (f32x4){0.f, 0.f, 0.f, 0.f};
        cur = nxt; cA = nA; cB = nB; ++ui;
    }
    PG8_WAIT_V(0);
    if (wr == 0) PG8_BAR;
    PG8_BAR;
    if constexpr (Epi::AFTER_DRAIN) { E.fused(acc, cur, wr, wc, fr, fq, lds, wid, lane); S.done(cur); }
    PG8_STAMP();
    if (STAMP && wid == 0) { stamps[lane] = lane < nts ? (((unsigned long long)(unsigned)ts_hi << 32) | (unsigned)ts_lo) : 0ull;
        if (lane == 62) stamps[62] = rt_entry; if (lane == 63) stamps[63] = (unsigned long long)wall_clock64(); }
#undef PG8_STAMP
#undef PG8_SA
#undef PG8_SB
#undef PG8_STAGE
#undef PG8_LDA
#undef PG8_LDB
#undef PG8_MMA
#undef PG8_WAIT_V
#undef PG8_WAIT_L
#undef PG8_BAR
#undef PG8_SCHED
}
}

#define DI __device__ __forceinline__
#define LAS __attribute__((address_space(3)))
typedef unsigned short u16;
typedef pg8::bf16x8 bf16x8;
typedef pg8::f32x4 f32x4;
typedef pg8::u32x4 u32x4;
typedef float f32x16 __attribute__((ext_vector_type(16)));
typedef unsigned u32x2 __attribute__((ext_vector_type(2)));
typedef __bf16 bf16v2 __attribute__((ext_vector_type(2)));
typedef float f32x2 __attribute__((ext_vector_type(2)));
#define MFMA32(a, b, c) __builtin_amdgcn_mfma_f32_32x32x16_bf16((a), (b), (c), 0, 0, 0)

constexpr int TOK = 8192, SEQ = 4096, DM = 4096, NPAD = 14592, NPJ = 14336, DIN = 14384;
constexpr float ALPHA = 1.4142135623730951f;
constexpr float HEPS = 1e-6f, LNEPS = 1e-5f;
constexpr float QSCALE = 0.08838834764831845f;
constexpr size_t WS_WIN = 0;
constexpr size_t WS_WOUT = WS_WIN + (size_t)2 * NPAD * 4096 * 2;
constexpr size_t WS_XB = WS_WOUT + (size_t)2 * 4096 * 4096 * 2;
constexpr size_t WS_XF = WS_XB + (size_t)TOK * DM * 2;
constexpr size_t WS_PROJ = WS_XF + (size_t)TOK * DM * 4;
constexpr size_t WS_PROJS = WS_PROJ + (size_t)TOK * NPJ * 2;
constexpr size_t WS_QP = WS_PROJS + (size_t)TOK * 64 * 4;
constexpr size_t WS_PP = WS_QP + (size_t)3072 * 16384;
constexpr size_t WS_KT = WS_PP + (size_t)3072 * 8192;
constexpr size_t WS_WW = WS_KT + (size_t)3072 * 16384;
constexpr size_t WS_DD = WS_WW + (size_t)2048 * 16384;
constexpr size_t WS_UU = WS_DD + (size_t)3072 * 512;
constexpr size_t WS_O = WS_UU + (size_t)1024 * 32768 + (size_t)2048 * 16384;
constexpr size_t WS_MIX = WS_O + (size_t)TOK * DM * 4;
constexpr size_t WS_Z = WS_MIX + (size_t)TOK * DM * 2;
constexpr size_t WS_BAR = WS_Z + (size_t)TOK * DM * 4;
constexpr size_t WS_END = WS_BAR + 16384;
constexpr int LDS_BYTES = 163840;
constexpr int NPHASE = 13;
#ifndef REPS
#define REPS 1,1,1,1,1,1,1
#endif
constexpr int REP_ARR[7] = {REPS};
constexpr int REP_CONV = REP_ARR[0], REP_G1 = REP_ARR[1], REP_PREP = REP_ARR[2], REP_SCAN = REP_ARR[3], REP_NORM = REP_ARR[4], REP_G2 = REP_ARR[5], REP_LN = REP_ARR[6];

struct Args {
    const float* x; const int* pos; const float* w_in; const float* w_a2; const float* b_a; const float* conv_w; const float* a_log; const float* dt_bias;
    const float* ret_g; const float* gla_g; const float* dn_g; const float* w_out; const float* ln_g; const float* ln_b;
    float* out; unsigned char* ws; int ph_lo, ph_hi;
};

DI unsigned pk(float lo, float hi) { f32x2 v = {lo, hi}; bf16v2 r = __builtin_convertvector(v, bf16v2); return __builtin_bit_cast(unsigned, r); }
typedef _Float16 f16x2 __attribute__((ext_vector_type(2)));
DI unsigned pkh(float lo, float hi) { f16x2 r = {(_Float16)lo, (_Float16)hi}; return __builtin_bit_cast(unsigned, r); }
DI float hlo(unsigned u) { return (float)__builtin_bit_cast(f16x2, u)[0]; }
DI float hhi(unsigned u) { return (float)__builtin_bit_cast(f16x2, u)[1]; }
DI float bf2f(u16 v) { return __uint_as_float((unsigned)v << 16); }
DI float bflo(unsigned u) { return __uint_as_float(u << 16); }
DI float bfhi(unsigned u) { return __uint_as_float(u & 0xffff0000u); }
DI int crow(int reg, int h) { return (reg & 3) + 8 * (reg >> 2) + 4 * h; }
DI f32x16 zero16() { f32x16 z;
#pragma unroll
    for (int i = 0; i < 16; ++i) z[i] = 0.f; return z; }
DI u32x4 pack8u(const f32x16& x, const int s) { u32x4 p = {pk(x[8 * s], x[8 * s + 1]), pk(x[8 * s + 2], x[8 * s + 3]), pk(x[8 * s + 4], x[8 * s + 5]), pk(x[8 * s + 6], x[8 * s + 7])}; return p; }
DI bf16x8 pack8(const f32x16& x, const int s) { return __builtin_bit_cast(bf16x8, pack8u(x, s)); }
DI bf16x8 ld_nat(const LAS float* p) { const f32x4 a = *(const LAS f32x4*)p; const f32x4 b = *(const LAS f32x4*)(p + 4);
    u32x4 r = {pk(a[0], a[1]), pk(a[2], a[3]), pk(b[0], b[1]), pk(b[2], b[3])}; return __builtin_bit_cast(bf16x8, r); }
DI bf16x8 ld_tr(const LAS float* p, const int ld) { u32x4 r = {pk(p[0], p[ld]), pk(p[2 * ld], p[3 * ld]), pk(p[4 * ld], p[5 * ld]), pk(p[6 * ld], p[7 * ld])}; return __builtin_bit_cast(bf16x8, r); }
template <int CTRL> DI float dpp_add(float x) { return x + __int_as_float(__builtin_amdgcn_update_dpp(0, __float_as_int(x), CTRL, 0xf, 0xf, true)); }
DI float row_sum16(float x) { x = dpp_add<0xB1>(x); x = dpp_add<0x4E>(x); x = dpp_add<0x141>(x); x = dpp_add<0x140>(x); return x; }
DI float rdl(float x, int l) { return __int_as_float(__builtin_amdgcn_readlane(__float_as_int(x), l)); }
DI float wsum64(float v) { v = row_sum16(v); return (rdl(v, 0) + rdl(v, 16)) + (rdl(v, 32) + rdl(v, 48)); }
DI void wsum64x8(float (&v)[8]) {
#pragma unroll
    for (int i = 0; i < 8; ++i) v[i] = dpp_add<0xB1>(v[i]);
#pragma unroll
    for (int i = 0; i < 8; ++i) v[i] = dpp_add<0x4E>(v[i]);
#pragma unroll
    for (int i = 0; i < 8; ++i) v[i] = dpp_add<0x141>(v[i]);
#pragma unroll
    for (int i = 0; i < 8; ++i) v[i] = dpp_add<0x140>(v[i]);
#pragma unroll
    for (int i = 0; i < 8; ++i) v[i] = (rdl(v[i], 0) + rdl(v[i], 16)) + (rdl(v[i], 32) + rdl(v[i], 48));
}
DI float wsum32(float v) { v = row_sum16(v); const float lo = rdl(v, 0) + rdl(v, 16), hi = rdl(v, 32) + rdl(v, 48); return (threadIdx.x & 32) ? hi : lo; }
DI void lds_barrier() { asm volatile("s_waitcnt lgkmcnt(0)" ::: "memory"); __builtin_amdgcn_s_barrier(); asm volatile("" ::: "memory"); }
DI float silu(float y) { return y * __builtin_amdgcn_rcpf(1.f + __expf(-y)); }
DI float softplus(float x) { return fmaxf(x, 0.f) + __logf(1.f + __expf(-fabsf(x))); }

struct EpiProj {
    static constexpr bool PERM = true, AFTER_DRAIN = false;
    u16* O;
    DI void operator()(const f32x4 (&acc)[2][2][4][2], const pg8::Unit& u, int wr, int wc, int fr, int fq) const {
        const int row0 = u.pm * 256 + wr * 64 + fr;
        const int col0 = u.pn * 256 + wc * 32 + 8 * fq;
#pragma unroll
        for (int ai = 0; ai < 2; ++ai)
#pragma unroll
            for (int m = 0; m < 4; ++m) { u16* rowp = O + (size_t)(row0 + ai * 128 + m * 16) * NPJ + col0;
#pragma unroll
                for (int bj = 0; bj < 2; ++bj) { const f32x4 v0 = acc[ai][bj][m][0], v1 = acc[ai][bj][m][1];
                    u32x4 o = {pk(v0[0], v0[1]), pk(v0[2], v0[3]), pk(v1[0], v1[1]), pk(v1[2], v1[3])}; *(u32x4*)(rowp + bj * 128) = o; } }
    }
};
struct EpiZ {
    static constexpr bool PERM = true, AFTER_DRAIN = false;
    u16* Z; const float* X; const u16* XH;
    DI void operator()(const f32x4 (&acc)[2][2][4][2], const pg8::Unit& u, int wr, int wc, int fr, int fq) const {
        const int row0 = u.pm * 256 + wr * 64 + fr, col0 = u.pn * 256 + wc * 32 + 8 * fq;
#pragma unroll
        for (int ai = 0; ai < 2; ++ai)
#pragma unroll
            for (int m = 0; m < 4; ++m) { const size_t ro = (size_t)(row0 + ai * 128 + m * 16) * DM + col0;
#pragma unroll
                for (int bj = 0; bj < 2; ++bj) { f32x4 x0, x1;
                    if (X) { x0 = *(const f32x4*)(X + ro + bj * 128); x1 = *(const f32x4*)(X + ro + bj * 128 + 4); }
                    else { const u32x4 xb = *(const u32x4*)(XH + ro + bj * 128); x0[0] = hlo(xb[0]); x0[1] = hhi(xb[0]); x0[2] = hlo(xb[1]); x0[3] = hhi(xb[1]); x1[0] = hlo(xb[2]); x1[1] = hhi(xb[2]); x1[2] = hlo(xb[3]); x1[3] = hhi(xb[3]); }
                    const f32x4 z0 = x0 * ALPHA + acc[ai][bj][m][0], z1 = x1 * ALPHA + acc[ai][bj][m][1];
                    u32x4 o = {pkh(z0[0], z0[1]), pkh(z0[2], z0[3]), pkh(z1[0], z1[1]), pkh(z1[2], z1[3])}; *(u32x4*)(Z + ro + bj * 128) = o; } }
    }
};
#define XB_TMO      128
#define XB_XCNT(j)  (256  + 64 * (j))
#define XB_XSUB(j)  (1280 + 64 * (j))
#define XB_XGEN(j)  (2304 + 64 * (j))
#define XB_TOP      3328
#define XB_TOPGEN   3392
#define XCD_BAR_WORDS 3456
#define XB_SPIN_CAP (1u << 18)

__device__ __forceinline__ unsigned xb_ld(unsigned* p)              { return __hip_atomic_load(p, __ATOMIC_RELAXED, __HIP_MEMORY_SCOPE_AGENT); }
__device__ __forceinline__ unsigned xb_add(unsigned* p, unsigned v) { return __hip_atomic_fetch_add(p, v, __ATOMIC_RELAXED, __HIP_MEMORY_SCOPE_AGENT); }
__device__ __forceinline__ unsigned xb_xcc_id() { return (unsigned)__builtin_amdgcn_s_getreg((3 << 11) | 20) & 0xFu; }
#define XB_SPIN(cond, bar) do { unsigned _sp = 0; while (cond) { __builtin_amdgcn_s_sleep(1); \
    if ((++_sp & 255u) == 0u) { if (xb_ld(&(bar)[XB_TMO])) break; if (_sp > XB_SPIN_CAP) { atomicAdd(&(bar)[XB_TMO], 1u); break; } } } } while (0)

struct XcdBarrier {
    unsigned* bar; unsigned x;
    volatile LAS unsigned* st;
};

__device__ __forceinline__ XcdBarrier xcd_barrier_post(unsigned* bar, volatile LAS unsigned* st) {
    XcdBarrier b; b.bar = bar; b.x = xb_xcc_id(); b.st = st;
    if (threadIdx.x == 0) (void)xb_add(&bar[XB_XCNT(b.x)], 1u);
    return b;
}
__device__ __forceinline__ void xcd_barrier_complete(unsigned* bar, unsigned x, unsigned& nloc, unsigned& nx) {
    const unsigned G = gridDim.x * gridDim.y * gridDim.z;
    unsigned sum, cnt, mine, sp = 0u;
    for (;;) {
        sum = 0u; cnt = 0u; mine = 0u;
#pragma unroll
        for (unsigned j = 0; j < 16; ++j) { const unsigned c = xb_ld(&bar[XB_XCNT(j)]); sum += c; cnt += (c > 0u) ? 1u : 0u; mine = (j == x) ? c : mine; }
        if (sum == G) break;
        __builtin_amdgcn_s_sleep(1);
        if ((++sp & 255u) == 0u) { if (xb_ld(&bar[XB_TMO])) break; if (sp > XB_SPIN_CAP) { atomicAdd(&bar[XB_TMO], 1u); break; } }
    }
    nloc = mine > 0u ? mine : 1u; nx = cnt > 0u ? cnt : 1u;
}

__device__ __forceinline__ void xcd_barrier(const XcdBarrier& b) {
    asm volatile("s_waitcnt vmcnt(0)" ::: "memory");
    __syncthreads();
    if (threadIdx.x == 0) {
        unsigned* bar = b.bar;
        __builtin_amdgcn_s_waitcnt(0);
        unsigned nloc = b.st[0], nx = b.st[1];
        if (nloc == 0u) { xcd_barrier_complete(bar, b.x, nloc, nx); b.st[0] = nloc; b.st[1] = nx; }
        const unsigned old = xb_add(&bar[XB_XSUB(b.x)], 1u);
        const unsigned gen = old / nloc;
        if (old + 1u == (gen + 1u) * nloc) {
            __builtin_amdgcn_fence(__ATOMIC_RELEASE, "agent");
            asm volatile("s_waitcnt vmcnt(0)" ::: "memory");
            const unsigned og = xb_add(&bar[XB_TOP], 1u);
            const unsigned tg = og / nx;
            if (og + 1u == (tg + 1u) * nx) xb_add(&bar[XB_TOPGEN], 1u);
            else XB_SPIN(xb_ld(&bar[XB_TOPGEN]) == tg, bar);
            __builtin_amdgcn_fence(__ATOMIC_ACQUIRE, "agent");
            xb_add(&bar[XB_XGEN(b.x)], 1u);
            asm volatile("s_waitcnt vmcnt(0)" ::: "memory");
        } else {
            XB_SPIN(xb_ld(&bar[XB_XGEN(b.x)]) == gen, bar);
            __builtin_amdgcn_fence(__ATOMIC_ACQUIRE, "agent");
            asm volatile("s_waitcnt vmcnt(0)" ::: "memory");
        }
    }
    __syncthreads();
}

DI int map_col(int np) { return np < 6144 ? np : (np < 14336 ? np + 16 : (np < 14352 ? np - 14336 + 6144 : (np < 14384 ? np : -1))); }
DI void phase_convert(const Args& a, LAS float* lds, const int t, const int vb, const int nvb, const int tile_lo, const int tile_hi, const bool do_x) {
    u16* WIN = (u16*)(a.ws + WS_WIN); u16* WOUT = (u16*)(a.ws + WS_WOUT);
    constexpr int T_IN = 64 * 228, T_OUT = 64 * 64, T_L = T_IN + T_OUT;
    const int r4 = t >> 4, q4 = (t & 15) * 4, nl2 = t >> 3, kq = (t & 7) * 8;
    for (int tp = tile_lo + 2 * vb; tp < tile_hi; tp += 2 * nvb) {
        f32x4 v[2][2]; u16* dstp[2];
#pragma unroll
        for (int u = 0; u < 2; ++u) {
            const int tile = tp + u; const int l = tile / T_L; int r = tile % T_L; const float* src; u16* dst; int ldw, kt, nt; const bool isin = r < T_IN;
            if (isin) { nt = r % 228; kt = r / 228; src = a.w_in + (size_t)l * 4096 * DIN; ldw = DIN; dst = WIN + (size_t)l * NPAD * 4096; }
            else { r -= T_IN; nt = r % 64; kt = r / 64; src = a.w_out + (size_t)l * 4096 * 4096; ldw = 4096; dst = WOUT + (size_t)l * 4096 * 4096; }
            const int np = nt * 64 + q4, n = isin ? map_col(np) : np;
#pragma unroll
            for (int i = 0; i < 2; ++i) { const int kl = r4 + 32 * i; v[u][i] = n >= 0 ? __builtin_nontemporal_load((const f32x4*)(src + (size_t)(kt * 64 + kl) * ldw + n)) : (f32x4){0.f, 0.f, 0.f, 0.f}; }
            dstp[u] = dst + (size_t)(nt * 64 + nl2) * 4096 + kt * 64 + kq;
        }
#pragma unroll
        for (int u = 0; u < 2; ++u)
#pragma unroll
            for (int i = 0; i < 2; ++i) { const int kl = r4 + 32 * i;
#pragma unroll
                for (int q = 0; q < 4; ++q) lds[u * 4160 + kl * 65 + q4 + q] = v[u][i][q]; }
        lds_barrier();
#pragma unroll
        for (int u = 0; u < 2; ++u) { float f[8];
#pragma unroll
            for (int j = 0; j < 8; ++j) f[j] = lds[u * 4160 + (kq + j) * 65 + nl2];
            u32x4 o = {pk(f[0], f[1]), pk(f[2], f[3]), pk(f[4], f[5]), pk(f[6], f[7])};
            *(u32x4*)dstp[u] = o; }
        lds_barrier();
    }
    if (do_x) {
        u32x4* XB = (u32x4*)(a.ws + WS_XB); const f32x4* X4 = (const f32x4*)a.x;
        for (size_t i = (size_t)vb * 512 + t; i < (size_t)TOK * DM / 8; i += (size_t)nvb * 512) {
            const f32x4 p = __builtin_nontemporal_load(X4 + 2 * i), q = __builtin_nontemporal_load(X4 + 2 * i + 1); u32x4 o = {pk(p[0], p[1]), pk(p[2], p[3]), pk(q[0], q[1]), pk(q[2], q[3])}; XB[i] = o; }
    }
}

DI void phase_skinny(const Args& a, int l, LAS float* lds, const int t, const int bid) {
    const int w = __builtin_amdgcn_readfirstlane(t >> 6), lane = t & 63, m = lane & 31, h = lane >> 5;
    const u16* XB = (const u16*)(a.ws + WS_XB); const u16* WS = (const u16*)(a.ws + WS_WIN) + ((size_t)l * NPAD + NPJ) * 4096; float* PS = (float*)(a.ws + WS_PROJS);
    for (int rb = bid; rb < 256; rb += gridDim.x) {
        const u16* pa = XB + (size_t)(rb * 32 + m) * 4096 + w * 512 + 8 * h; const u16* pb0 = WS + (size_t)m * 4096 + w * 512 + 8 * h; const u16* pb1 = pb0 + (size_t)32 * 4096;
        f32x16 c0 = zero16(), c1 = zero16();
#pragma unroll 8
        for (int kb = 0; kb < 32; ++kb) { const bf16x8 av = *(const bf16x8*)(pa + 16 * kb), b0 = *(const bf16x8*)(pb0 + 16 * kb), b1 = *(const bf16x8*)(pb1 + 16 * kb);
            c0 = MFMA32(av, b0, c0); c1 = MFMA32(av, b1, c1); }
#pragma unroll
        for (int reg = 0; reg < 16; ++reg) { lds[w * 2048 + reg * 64 + lane] = c0[reg]; lds[w * 2048 + 1024 + reg * 64 + lane] = c1[reg]; }
        lds_barrier();
#pragma unroll
        for (int q = 0; q < 4; ++q) { const int idx = t + 512 * q; float s = 0.f;
#pragma unroll
            for (int ww = 0; ww < 8; ++ww) s += lds[ww * 2048 + idx];
            const int ln = idx & 63, reg = (idx >> 6) & 15, nt = idx >> 10;
            PS[(size_t)(rb * 32 + crow(reg, ln >> 5)) * 64 + nt * 32 + (ln & 31)] = s; }
        lds_barrier();
    }
}

constexpr int L_QS = 0, L_KS = 8448, L_VS = 16896, L_AS = 25344, L_TU = 29696, L_TW = 34048, L_MISC = 38400;

#define SCHED_BAR __builtin_amdgcn_sched_barrier(0)
DI f32x16 prod_nn(const LAS float* Xa, const LAS float* Xb, int mt, int nt, int lane) {
    const int r = lane & 31, h = lane >> 5; f32x16 acc = zero16();
    const LAS float* pa = Xa + (mt * 32 + r) * 132 + 8 * h; const LAS float* pb = Xb + (nt * 32 + r) * 132 + 8 * h;
#pragma unroll
    for (int half = 0; half < 2; ++half) {
        f32x4 va[4][2], vb[4][2];
#pragma unroll
        for (int kb = 0; kb < 4; ++kb) { const int ko = 16 * (4 * half + kb); va[kb][0] = *(const LAS f32x4*)(pa + ko); va[kb][1] = *(const LAS f32x4*)(pa + ko + 4); vb[kb][0] = *(const LAS f32x4*)(pb + ko); vb[kb][1] = *(const LAS f32x4*)(pb + ko + 4); }
        SCHED_BAR;
#pragma unroll
        for (int kb = 0; kb < 4; ++kb) {
            u32x4 ua = {pk(va[kb][0][0], va[kb][0][1]), pk(va[kb][0][2], va[kb][0][3]), pk(va[kb][1][0], va[kb][1][1]), pk(va[kb][1][2], va[kb][1][3])};
            u32x4 ub = {pk(vb[kb][0][0], vb[kb][0][1]), pk(vb[kb][0][2], vb[kb][0][3]), pk(vb[kb][1][0], vb[kb][1][1]), pk(vb[kb][1][2], vb[kb][1][3])};
            acc = MFMA32(__builtin_bit_cast(bf16x8, ua), __builtin_bit_cast(bf16x8, ub), acc); }
    }
    return acc;
}
DI void st_acc(unsigned char* dst, const f32x16& x, int lane) { *(u32x4*)(dst + lane * 16) = pack8u(x, 0); *(u32x4*)(dst + 1024 + lane * 16) = pack8u(x, 1); }
DI void qstore(unsigned char* dst, const LAS float* X, const LAS float* rs, int t0, int nth) {
    for (int lb = t0; lb < 1024; lb += nth) { const int blk = lb >> 6, ln = lb & 63, mt = blk >> 3, st = (blk >> 1) & 3, kb = blk & 1, m = ln & 31, h = ln >> 5, i = 32 * mt + m;
        const LAS float* p = X + i * 132 + 32 * st + 16 * kb + 4 * h; const f32x4 a = *(const LAS f32x4*)p, b = *(const LAS f32x4*)(p + 8); const float s = rs ? rs[i] : 1.f;
        u32x4 o = {pk(a[0] * s, a[1] * s), pk(a[2] * s, a[3] * s), pk(b[0] * s, b[1] * s), pk(b[2] * s, b[3] * s)}; *(u32x4*)(dst + blk * 1024 + ln * 16) = o; }
}
DI void ctstore(unsigned char* dst, const LAS float* X, const LAS float* rs, int t0, int nth) {
    for (int lb = t0; lb < 1024; lb += nth) { const int blk = lb >> 6, ln = lb & 63, ct = blk >> 2, jt = (blk >> 1) & 1, kb = blk & 1, n = ln & 31, h = ln >> 5; float f[8], s[8];
#pragma unroll
        for (int jj = 0; jj < 8; ++jj) { const int j = 32 * jt + 16 * kb + 8 * (jj >> 2) + 4 * h + (jj & 3); f[jj] = X[j * 132 + 32 * ct + n]; s[jj] = rs ? rs[j] : 1.f; }
        SCHED_BAR;
        u32x4 o = {pk(f[0] * s[0], f[1] * s[1]), pk(f[2] * s[2], f[3] * s[3]), pk(f[4] * s[4], f[5] * s[5]), pk(f[6] * s[6], f[7] * s[7])}; *(u32x4*)(dst + blk * 1024 + ln * 16) = o; }
}

DI void dn_raw_geom(int t, unsigned (&roff)[7], unsigned& padm) {
    padm = 0u;
#pragma unroll
    for (int q = 0; q < 7; ++q) { const int cid = t + 512 * q, srow = cid >> 4, part = cid & 15, seg = srow / 67, rr = srow - seg * 67;
        roff[q] = (unsigned)(rr * NPJ + seg * 2048 + part * 8); if (rr < 3 || cid >= 3216) padm |= (rr < 3 ? 1u : 0u) << q | (cid >= 3216 ? 0x100u : 0u) << q; }
}
DI void dn_raw_load(u32x4 (&R)[7], const u16* PROJ, int gi, const unsigned (&roff)[7], unsigned padm) {
    const int n = gi & 63, bh = gi >> 6, hh = bh & 15, b = bh >> 4;
    const u16* base = PROJ + ((size_t)(b * SEQ + n * 64) - 3) * NPJ + 6144 + hh * 128;
    const unsigned skip = (n == 0 ? (padm & 0x7fu) : 0u) | (padm >> 8);
#pragma unroll
    for (int q = 0; q < 7; ++q) { u32x4 v = {0u, 0u, 0u, 0u}; if (!((skip >> q) & 1u)) v = *(const u32x4*)(base + roff[q]); R[q] = v; }
}

DI void dn_gates(const Args& a, int l, const float* PROJS, int gi, int lane, LAS float* M, float* DDd) {
    const int n = gi & 63, bh = gi >> 6, hh = bh & 15, b = bh >> 4; const int row = b * SEQ + n * 64 + lane;
    const float bt = __builtin_amdgcn_rcpf(1.f + __expf(-PROJS[(size_t)row * 64 + 16 + hh]));
    float gcv = -__expf(a.a_log[l * 16 + hh]) * softplus(PROJS[(size_t)row * 64 + 32 + hh] + a.dt_bias[l * 16 + hh]);
#pragma unroll
    for (int o = 1; o < 64; o <<= 1) { const float up = __shfl_up(gcv, o); if (lane >= o) gcv += up; }
    const float glast = __shfl(gcv, 63);
    M[lane] = bt; M[64 + lane] = gcv; M[128 + lane] = __expf(gcv); M[192 + lane] = __expf(glast - gcv);
    DDd[lane] = __expf(glast); DDd[lane + 64] = __expf(glast);
}

DI void phase_prep(const Args& a, int l, LAS float* lds, const int tid_in, const int bid) {
    LAS float* QS = lds + L_QS; LAS float* KS = lds + L_KS; LAS float* VS = lds + L_VS; LAS float* AS = lds + L_AS; LAS float* TU = lds + L_TU; LAS float* TW = lds + L_TW;
    LAS float* GA = lds + L_MISC + 256; LAS float* SEG = lds + L_MISC + 1280;
    int gpar = 0; bool have_gates = false;
    LAS u16* RAW = (LAS u16*)AS;
    const u16* PROJ = (const u16*)(a.ws + WS_PROJ); const float* PROJS = (const float*)(a.ws + WS_PROJS);
    u32x4 RW[7]; bool have_raw = false; unsigned roff[7], padm; dn_raw_geom(tid_in, roff, padm);
    for (int g = bid; g < 3072; g += gridDim.x) {
        int t = tid_in; asm volatile("" : "+v"(t));
        const int w = __builtin_amdgcn_readfirstlane(t >> 6), lane = t & 63, r = lane & 31, h2 = lane >> 5;
        unsigned char* QPd = a.ws + WS_QP + (size_t)g * 16384; unsigned char* PPd = a.ws + WS_PP + (size_t)g * 8192; unsigned char* KTd = a.ws + WS_KT + (size_t)g * 16384;
        float* DDd = (float*)(a.ws + WS_DD + (size_t)g * 512);
        if (g < 1024) {
            const bool isret = g < 512; const int gi = isret ? g : g - 512; const int n = gi & 63, bh = gi >> 6, hh = bh & 3, b = bh >> 2; const int rowbase = b * SEQ + n * 64;
            unsigned char* UUd = a.ws + WS_UU + (size_t)g * 32768;
            const int vcol0 = (isret ? 1024 : 4096) + hh * 256;
            u32x4 vt[4];
#pragma unroll
            for (int q = 0; q < 4; ++q) { const int cid = t + 512 * q, row = cid >> 5, part = cid & 31; vt[q] = *(const u32x4*)(PROJ + (size_t)(rowbase + row) * NPJ + vcol0 + part * 8); }
            if (isret) {
                const int c = t & 63, seg = t >> 6;
                const float inv = __builtin_amdgcn_exp2f(-(float)c * (13.287712379549449f / 64.f));
                const float lg2 = __builtin_amdgcn_logf(1.f - __builtin_amdgcn_exp2f(-5.f - (float)hh));
#pragma unroll
                for (int ii = 0; ii < 8; ++ii) { const int i = seg * 8 + ii, row = rowbase + i;
                    const float ang = (float)a.pos[row] * inv; float rev = ang * 0.15915494309189535f; rev -= floorf(rev);
                    const float sn = __builtin_amdgcn_sinf(rev), cs = __builtin_amdgcn_cosf(rev);
                    const u16* pr = PROJ + (size_t)row * NPJ + hh * 128 + c;
                    const float q1 = bf2f(pr[0]), q2 = bf2f(pr[64]), k1 = bf2f(pr[512]), k2 = bf2f(pr[512 + 64]);
                    const float qa = q1 * cs - q2 * sn, qb = q1 * sn + q2 * cs, ka = k1 * cs - k2 * sn, kb = k1 * sn + k2 * cs;
                    const float e1 = __builtin_amdgcn_exp2f((float)(i + 1) * lg2) , ei = __builtin_amdgcn_exp2f(-(float)(i + 1) * lg2), ez = __builtin_amdgcn_exp2f((float)(63 - i) * lg2);
                    QS[i * 132 + c] = qa * (QSCALE * e1); QS[i * 132 + c + 64] = qb * (QSCALE * e1);
                    KS[i * 132 + c] = ka * ei; KS[i * 132 + c + 64] = kb * ei;
                    VS[i * 132 + c] = ka * ez; VS[i * 132 + c + 64] = kb * ez; }
                if (t < 128) DDd[t] = __builtin_amdgcn_exp2f(64.f * lg2);
            } else {
                if (t < 256) { const int row = t >> 2, part = t & 3; *(LAS f32x4*)(GA + row * 16 + part * 4) = *(const f32x4*)(PROJS + (size_t)(rowbase + row) * 64 + part * 4); }
                lds_barrier();
                const int c = t & 127, seg = t >> 7;
                float wv[16];
#pragma unroll
                for (int q = 0; q < 16; ++q) wv[q] = a.w_a2[(size_t)l * 16 * 512 + q * 512 + hh * 128 + c];
                const float bias = a.b_a[l * 512 + hh * 128 + c];
                float bl[16]; float run = 0.f;
#pragma unroll
                for (int ii = 0; ii < 16; ++ii) { const int i = seg * 16 + ii; float z = bias;
#pragma unroll
                    for (int q4 = 0; q4 < 4; ++q4) { const f32x4 gv = *(const LAS f32x4*)(GA + i * 16 + q4 * 4); z += gv[0] * wv[4 * q4] + gv[1] * wv[4 * q4 + 1] + gv[2] * wv[4 * q4 + 2] + gv[3] * wv[4 * q4 + 3]; }
                    const float ls = fminf(z, 0.f) - __logf(1.f + __expf(-fabsf(z)));
                    run += ls * (1.f / 16.f); bl[ii] = run; }
                SEG[seg * 128 + c] = run;
                lds_barrier();
                float off = 0.f, tot = 0.f;
#pragma unroll
                for (int s = 0; s < 4; ++s) { const float sv = SEG[s * 128 + c]; tot += sv; if (s < seg) off += sv; }
#pragma unroll
                for (int ii = 0; ii < 16; ++ii) { const int i = seg * 16 + ii, row = rowbase + i; const float bi = bl[ii] + off;
                    const u16* pr = PROJ + (size_t)row * NPJ + 3072 + hh * 128 + c;
                    const float q = bf2f(pr[0]) * QSCALE, k = bf2f(pr[512]);
                    QS[i * 132 + c] = q * __expf(bi); KS[i * 132 + c] = k * __expf(-bi); VS[i * 132 + c] = k * __expf(tot - bi); }
                if (seg == 0) DDd[c] = __expf(tot);
            }
#pragma unroll
            for (int q = 0; q < 4; ++q) { const int cid = t + 512 * q, row = cid >> 5, part = cid & 31; *(LAS u32x4*)(RAW + row * 264 + part * 8) = vt[q]; }
            lds_barrier();
#ifdef PROBE_RGFIN
            for (int prg_ = 0; prg_ < 2; ++prg_) {
#endif
            if (w < 4) {
                const int jt = w >> 1, it = w & 1; f32x16 acc = zero16();
                if (jt <= it) { acc = prod_nn(KS, QS, jt, it, lane);
#pragma unroll
                    for (int reg = 0; reg < 16; ++reg) { const int j = 32 * jt + crow(reg, h2), i = 32 * it + r; acc[reg] = (i >= j) ? acc[reg] : 0.f; } }
                st_acc(PPd + ((it * 2 + jt) * 2) * 1024, acc, lane);
            } else { qstore(QPd, QS, nullptr, t - 256, 256); ctstore(KTd, VS, nullptr, t - 256, 256); }
            for (int lb = t; lb < 2048; lb += 512) { const int blk = lb >> 6, ln = lb & 63, ct = blk >> 2, jt = (blk >> 1) & 1, kb = blk & 1, nn = ln & 31, hh2 = ln >> 5; unsigned f[8];
#pragma unroll
                for (int jj = 0; jj < 8; ++jj) { const int j = 32 * jt + 16 * kb + 8 * (jj >> 2) + 4 * hh2 + (jj & 3); f[jj] = RAW[j * 264 + 32 * ct + nn]; }
                SCHED_BAR;
                u32x4 o = {f[0] | (f[1] << 16), f[2] | (f[3] << 16), f[4] | (f[5] << 16), f[6] | (f[7] << 16)}; *(u32x4*)(UUd + blk * 1024 + ln * 16) = o; }
#ifdef PROBE_RGFIN
            }
#endif
            lds_barrier();
        } else {
            const int gi = g - 1024, n = gi & 63, bh = gi >> 6, hh = bh & 15, b = bh >> 4; const int rowbase = b * SEQ + n * 64;
            unsigned char* UUd = a.ws + WS_UU + (size_t)1024 * 32768 + (size_t)gi * 16384; unsigned char* WWd = a.ws + WS_WW + (size_t)gi * 16384;
            if (!have_raw) dn_raw_load(RW, PROJ, gi, roff, padm);
#pragma unroll
            for (int q = 0; q < 7; ++q) { if (!((padm >> (8 + q)) & 1u)) *(LAS u32x4*)(RAW + (t + 512 * q) * 8) = RW[q]; }
            LAS float* MG = lds + L_MISC + gpar * 1792; LAS float* BETA = MG; LAS float* GC = MG + 64; LAS float* EQ = MG + 128; LAS float* EK = MG + 192;
            f32x2 cwv[3][4];
#pragma unroll
            for (int mtx = 0; mtx < 3; ++mtx)
#pragma unroll
                for (int tap = 0; tap < 4; ++tap) cwv[mtx][tap] = *(const f32x2*)(a.conv_w + (size_t)l * 4 * 6144 + tap * 6144 + mtx * 2048 + hh * 128 + 2 * lane);
            if (!have_gates && w == 0) dn_gates(a, l, PROJS, gi, lane, MG, DDd);
            lds_barrier();
            {
                float sq[8], sk[8]; f32x2 yq[8], yk[8];
#pragma unroll
                for (int mtx = 0; mtx < 3; ++mtx) { const f32x2 w0 = cwv[mtx][0], w1 = cwv[mtx][1], w2 = cwv[mtx][2], w3 = cwv[mtx][3];
                    const LAS unsigned* pc = (const LAS unsigned*)(RAW + (mtx * 67 + w * 8) * 128) + lane; f32x2 xr[11];
#pragma unroll
                    for (int ii = 0; ii < 11; ++ii) { const unsigned u = pc[ii * 64]; xr[ii] = (f32x2){bflo(u), bfhi(u)}; }
#pragma unroll
                    for (int ii = 0; ii < 8; ++ii) { f32x2 y = w0 * xr[ii] + w1 * xr[ii + 1] + w2 * xr[ii + 2] + w3 * xr[ii + 3];
                        const f32x2 en = y * (-1.4426950408889634f); f32x2 d; d[0] = __builtin_amdgcn_exp2f(en[0]); d[1] = __builtin_amdgcn_exp2f(en[1]); d = d + 1.0f;
                        f32x2 rc; rc[0] = __builtin_amdgcn_rcpf(d[0]); rc[1] = __builtin_amdgcn_rcpf(d[1]); y = y * rc;
                        if (mtx == 0) { yq[ii] = y; const f32x2 p = y * y; sq[ii] = p[0] + p[1]; } else if (mtx == 1) { yk[ii] = y; const f32x2 p = y * y; sk[ii] = p[0] + p[1]; }
                        else *(LAS f32x2*)(VS + (w * 8 + ii) * 132 + 2 * lane) = y; } }
                wsum64x8(sq); wsum64x8(sk);
#pragma unroll
                for (int ii = 0; ii < 8; ++ii) { const float rq = __builtin_amdgcn_rsqf(sq[ii] + HEPS) * QSCALE, rk = __builtin_amdgcn_rsqf(sk[ii] + HEPS); const int row = w * 8 + ii;
                    *(LAS f32x2*)(QS + row * 132 + 2 * lane) = yq[ii] * rq; *(LAS f32x2*)(KS + row * 132 + 2 * lane) = yk[ii] * rk; }
            }
            lds_barrier();
            if (w < 4) {
                const int it = w >> 1, jt = w & 1; f32x16 acc = zero16();
                if (jt <= it) { acc = prod_nn(KS, KS, it, jt, lane);
#pragma unroll
                    for (int g4 = 0; g4 < 4; ++g4) { const f32x4 gci = *(const LAS f32x4*)(GC + 32 * it + 8 * g4 + 4 * h2), bei = *(const LAS f32x4*)(BETA + 32 * it + 8 * g4 + 4 * h2); const float gcj = GC[32 * jt + r];
#pragma unroll
                        for (int tt = 0; tt < 4; ++tt) { const int reg = 4 * g4 + tt, i = 32 * it + crow(reg, h2), j = 32 * jt + r; const float dl = (i > j) ? gci[tt] - gcj : 0.f;
                            acc[reg] = (i > j) ? acc[reg] * bei[tt] * __expf(dl) : 0.f; } } }
#pragma unroll
                for (int reg = 0; reg < 16; ++reg) AS[(32 * it + crow(reg, h2)) * 68 + 32 * jt + r] = acc[reg];
            } else {
                const int jt = (w - 4) >> 1, it = (w - 4) & 1; f32x16 acc = zero16();
                if (jt <= it) { acc = prod_nn(KS, QS, jt, it, lane);
#pragma unroll
                    for (int g4 = 0; g4 < 4; ++g4) { const f32x4 gcj = *(const LAS f32x4*)(GC + 32 * jt + 8 * g4 + 4 * h2); const float gci = GC[32 * it + r];
#pragma unroll
                        for (int tt = 0; tt < 4; ++tt) { const int reg = 4 * g4 + tt, j = 32 * jt + crow(reg, h2), i = 32 * it + r; const float dl = (i >= j) ? gci - gcj[tt] : 0.f;
                            acc[reg] = (i >= j) ? acc[reg] * __expf(dl) : 0.f; } } }
                st_acc(PPd + ((it * 2 + jt) * 2) * 1024, acc, lane);
            }
            lds_barrier();
            {
                const int gn = g + gridDim.x; have_raw = gn < 3072;
                if (have_raw) dn_raw_load(RW, PROJ, gn - 1024, roff, padm);
            }
#ifdef PROBE_SOLVE
            for (int prep_ = 0; prep_ < 2; ++prep_)
#endif
            if (w == 0) {
                f32x2 Tc[16];
                const int hb = lane >> 5, c = lane & 31;
                LAS float* ASo = AS + hb * (32 * 68 + 32); LAS float* TUo = TU + hb * (32 * 68 + 32) + c; LAS float* TWo = TW + hb * (32 * 68 + 32) + c;
                asm volatile("" : "+v"(ASo)); asm volatile("" : "+v"(TUo)); asm volatile("" : "+v"(TWo));
#pragma unroll
                for (int i = 0; i < 16; ++i) Tc[i] = (f32x2){0.f, 0.f};
#pragma unroll
                for (int i = 0; i < 32; ++i) { f32x2 a01 = {0.f, 0.f}, a23 = {0.f, 0.f};
#pragma unroll
                    for (int j = 0; j < i; j += 4) { const f32x4 av = *(const LAS f32x4*)(ASo + i * 68 + j); a01 += (f32x2){av[0], av[1]} * Tc[j >> 1]; a23 += (f32x2){av[2], av[3]} * Tc[(j >> 1) + 1]; }
                    const float tv = ((c == i) ? 1.f : 0.f) - ((a01[0] + a01[1]) + (a23[0] + a23[1]));
                    if (i & 1) Tc[i >> 1][1] = tv; else Tc[i >> 1][0] = tv; }
                const float bc = BETA[lane], bw = bc * EQ[lane];
#pragma unroll
                for (int i = 0; i < 32; ++i) { const float tv = (i & 1) ? Tc[i >> 1][1] : Tc[i >> 1][0];
                    ASo[i * 68 + c] = tv;
                    TUo[i * 68] = tv * bc; TWo[i * 68] = tv * bw;
                    }
                { LAS float* zu = TU + hb * 68 + 32 + c; LAS float* zw = TW + hb * 68 + 32 + c;
#pragma unroll
                    for (int i = 0; i < 16; ++i) { zu[i * 136] = 0.f; zw[i * 136] = 0.f; } }
            } else if (w == 7 && have_raw) { dn_gates(a, l, PROJS, g + gridDim.x - 1024, lane, lds + L_MISC + (gpar ^ 1) * 1792, (float*)(a.ws + WS_DD + (size_t)(g + gridDim.x) * 512)); }
            else { qstore(QPd, QS, EQ, t - 64, have_raw ? 384 : 448); ctstore(KTd, KS, EK, t - 64, have_raw ? 384 : 448); }
            have_gates = have_raw; gpar ^= 1;
            lds_barrier();
            if (w == 0) {
                f32x16 X = zero16(), T21 = zero16();
#pragma unroll
                for (int kb = 0; kb < 2; ++kb) X = MFMA32(ld_nat(AS + (32 + r) * 68 + 16 * kb + 8 * h2), ld_tr(AS + (16 * kb + 8 * h2) * 68 + r, 68), X);
#pragma unroll
                for (int s = 0; s < 2; ++s) { const LAS float* p = AS + (32 + r) * 68 + 32 + 16 * s + 4 * h2; const f32x4 a = *(const LAS f32x4*)p, b = *(const LAS f32x4*)(p + 8);
                    u32x4 ua = {pk(a[0], a[1]), pk(a[2], a[3]), pk(b[0], b[1]), pk(b[2], b[3])};
                    T21 = MFMA32(__builtin_bit_cast(bf16x8, ua), pack8(X, s), T21); }
                const float bc = BETA[r], bw = bc * EQ[r];
#pragma unroll
                for (int reg = 0; reg < 16; ++reg) { const int i = 32 + crow(reg, h2); TU[i * 68 + r] = -T21[reg] * bc; TW[i * 68 + r] = -T21[reg] * bw; }
            }
            lds_barrier();
#ifdef PROBE_D5
            for (int prep_ = 0; prep_ < 2; ++prep_)
#endif
            {
                const int it = w >> 2, ct = w & 3; f32x16 au = zero16(), aw = zero16();
                f32x4 tu[4][2], tw[4][2]; float vv[4][8], kv[4][8];
#pragma unroll
                for (int kb = 0; kb < 4; ++kb) { const LAS float* pu = TU + (32 * it + r) * 68 + 16 * kb + 8 * h2; const LAS float* pw = TW + (32 * it + r) * 68 + 16 * kb + 8 * h2;
                    tu[kb][0] = *(const LAS f32x4*)pu; tu[kb][1] = *(const LAS f32x4*)(pu + 4); tw[kb][0] = *(const LAS f32x4*)pw; tw[kb][1] = *(const LAS f32x4*)(pw + 4);
                    const LAS float* pv = VS + (16 * kb + 8 * h2) * 132 + 32 * ct + r; const LAS float* pk2 = KS + (16 * kb + 8 * h2) * 132 + 32 * ct + r;
#pragma unroll
                    for (int jj = 0; jj < 8; ++jj) { vv[kb][jj] = pv[jj * 132]; kv[kb][jj] = pk2[jj * 132]; } }
                SCHED_BAR;
#pragma unroll
                for (int kb = 0; kb < 4; ++kb) {
                    u32x4 xa = {pk(tu[kb][0][0], tu[kb][0][1]), pk(tu[kb][0][2], tu[kb][0][3]), pk(tu[kb][1][0], tu[kb][1][1]), pk(tu[kb][1][2], tu[kb][1][3])};
                    u32x4 xb = {pk(vv[kb][0], vv[kb][1]), pk(vv[kb][2], vv[kb][3]), pk(vv[kb][4], vv[kb][5]), pk(vv[kb][6], vv[kb][7])};
                    u32x4 ya = {pk(kv[kb][0], kv[kb][1]), pk(kv[kb][2], kv[kb][3]), pk(kv[kb][4], kv[kb][5]), pk(kv[kb][6], kv[kb][7])};
                    u32x4 yb = {pk(tw[kb][0][0], tw[kb][0][1]), pk(tw[kb][0][2], tw[kb][0][3]), pk(tw[kb][1][0], tw[kb][1][1]), pk(tw[kb][1][2], tw[kb][1][3])};
                    au = MFMA32(__builtin_bit_cast(bf16x8, xa), __builtin_bit_cast(bf16x8, xb), au);
                    aw = MFMA32(__builtin_bit_cast(bf16x8, ya), __builtin_bit_cast(bf16x8, yb), aw); }
#pragma unroll
                for (int reg = 0; reg < 16; ++reg) aw[reg] = -aw[reg];
                st_acc(UUd + ((ct * 2 + it) * 2) * 1024, au, lane);
                st_acc(WWd + ((it * 4 + ct) * 2) * 1024, aw, lane);
            }
            lds_barrier();
        }
    }
}
constexpr int SB_QP = 0, SB_PP = 16384, SB_KT = 24576, SB_WW = 40960, SB_UU = 57344, SB_DD = 73728, SB_SIZE = 74240;
#define GAS __attribute__((address_space(1)))
template <bool DN, bool DVEC> DI void scan_compute(LAS unsigned char* lds, u16* Ob, const int w, const int lane) {
    f32x16 S[4];
#pragma unroll
    for (int st = 0; st < 4; ++st) S[st] = zero16();
    const unsigned loff = (unsigned)((lane & 31) * DM + 8 * (lane >> 5)) * 2u;
    lds_barrier();
#define LD4(dst, o0, o1, o2, o3) do { dst[0] = *(const LAS bf16x8*)(bufp + (o0)); dst[1] = *(const LAS bf16x8*)(bufp + (o1)); dst[2] = *(const LAS bf16x8*)(bufp + (o2)); dst[3] = *(const LAS bf16x8*)(bufp + (o3)); } while (0)
#define LD_W(dst, st) LD4(dst, SB_WW + (st) * 2048, SB_WW + 8192 + (st) * 2048, SB_WW + (st) * 2048 + 1024, SB_WW + 8192 + (st) * 2048 + 1024)
#define LD_Q(dst, st) LD4(dst, SB_QP + (st) * 2048, SB_QP + 8192 + (st) * 2048, SB_QP + (st) * 2048 + 1024, SB_QP + 8192 + (st) * 2048 + 1024)
#define LD_K(dst, g) LD4(dst, SB_KT + ((g) >> 1) * 8192 + ((g) & 1) * 2048, SB_KT + ((g) >> 1) * 8192 + 4096 + ((g) & 1) * 2048, SB_KT + ((g) >> 1) * 8192 + ((g) & 1) * 2048 + 1024, SB_KT + ((g) >> 1) * 8192 + 4096 + ((g) & 1) * 2048 + 1024)
#define MF_V(A, b0, b1) do { vn[0] = MFMA32(A[0], b0, vn[0]); vn[1] = MFMA32(A[1], b0, vn[1]); vn[0] = MFMA32(A[2], b1, vn[0]); vn[1] = MFMA32(A[3], b1, vn[1]); } while (0)
#define MF_O(A, b0, b1, first) do { o[0] = MFMA32(b0, A[0], (first) ? zero16() : o[0]); o[1] = MFMA32(b0, A[1], (first) ? zero16() : o[1]); o[0] = MFMA32(b1, A[2], o[0]); o[1] = MFMA32(b1, A[3], o[1]); } while (0)
#define MF_S(A, g) do { S[2 * ((g) >> 1)] = MFMA32(A[0], vbb[(g) & 1][0], S[2 * ((g) >> 1)]); S[2 * ((g) >> 1) + 1] = MFMA32(A[1], vbb[(g) & 1][0], S[2 * ((g) >> 1) + 1]); \
        S[2 * ((g) >> 1)] = MFMA32(A[2], vbb[(g) & 1][1], S[2 * ((g) >> 1)]); S[2 * ((g) >> 1) + 1] = MFMA32(A[3], vbb[(g) & 1][1], S[2 * ((g) >> 1) + 1]); } while (0)
#define SCHED __builtin_amdgcn_sched_barrier(0)
    for (int n = 0; n < 64; ++n) {
        const LAS unsigned char* bufp = lds + (n & 1) * SB_SIZE + lane * 16;
        bf16x8 F[8];
        const LAS u32x4* up = (const LAS u32x4*)(bufp + SB_UU + w * 4096);
        f32x16 vn[2]; bf16x8 vbb[2][2];
#pragma unroll
        for (int jt = 0; jt < 2; ++jt)
#pragma unroll
            for (int kb = 0; kb < 2; ++kb) { const u32x4 v = up[(jt * 2 + kb) * 64];
                if (DN) {
#pragma unroll
                    for (int q = 0; q < 4; ++q) { vn[jt][8 * kb + 2 * q] = bflo(v[q]); vn[jt][8 * kb + 2 * q + 1] = bfhi(v[q]); } }
                else vbb[jt][kb] = __builtin_bit_cast(bf16x8, v); }
        f32x16 o[2]; bf16x8 s0, s1;
#define PACK_V() do { _Pragma("unroll") for (int jt = 0; jt < 2; ++jt) { vbb[jt][0] = pack8(vn[jt], 0); vbb[jt][1] = pack8(vn[jt], 1); } } while (0)
#define SCALE_S() do { if (DVEC) { const LAS float* dp = (const LAS float*)(lds + (n & 1) * SB_SIZE + SB_DD) + 4 * (lane >> 5); \
            _Pragma("unroll") for (int st = 0; st < 4; ++st) _Pragma("unroll") for (int gq = 0; gq < 4; ++gq) { const f32x4 dv = *(const LAS f32x4*)(dp + 32 * st + 8 * gq); \
                _Pragma("unroll") for (int q = 0; q < 4; ++q) S[st][4 * gq + q] *= dv[q]; } } \
          else { const float dsc = *(const LAS float*)(lds + (n & 1) * SB_SIZE + SB_DD); _Pragma("unroll") for (int st = 0; st < 4; ++st) S[st] = S[st] * dsc; } } while (0)
#define STORE_O() do { GAS char* Op = (GAS char*)(Ob + (size_t)(n * 64) * DM) + loff; \
            _Pragma("unroll") for (int it = 0; it < 2; ++it) _Pragma("unroll") for (int p = 0; p < 2; ++p) { const int g = 2 * p; \
                unsigned ax = pk(o[it][4 * g], o[it][4 * g + 1]), ay = pk(o[it][4 * g + 2], o[it][4 * g + 3]), bx = pk(o[it][4 * g + 4], o[it][4 * g + 5]), by = pk(o[it][4 * g + 6], o[it][4 * g + 7]); \
                { auto rx = __builtin_amdgcn_permlane32_swap(ax, bx, false, false); ax = rx[0]; bx = rx[1]; } \
                { auto ry = __builtin_amdgcn_permlane32_swap(ay, by, false, false); ay = ry[0]; by = ry[1]; } \
                u32x4 ov = {ax, ay, bx, by}; *(GAS u32x4*)(Op + (size_t)(32 * it) * DM * 2 + 32 * p) = ov; } } while (0)
        if (DN) {
            F[0] = *(const LAS bf16x8*)(bufp + SB_WW + 0);
            F[1] = *(const LAS bf16x8*)(bufp + SB_WW + 8192);
            F[2] = *(const LAS bf16x8*)(bufp + SB_WW + 1024);
            F[3] = *(const LAS bf16x8*)(bufp + SB_WW + 9216);
            F[4] = *(const LAS bf16x8*)(bufp + SB_QP + 0);
            F[5] = *(const LAS bf16x8*)(bufp + SB_QP + 8192);
            F[6] = *(const LAS bf16x8*)(bufp + SB_QP + 1024);
            SCHED;
            F[7] = *(const LAS bf16x8*)(bufp + SB_QP + 9216); s0 = pack8(S[0], 0); s1 = pack8(S[0], 1); vn[0] = MFMA32(F[0], s0, vn[0]); SCHED;
            F[0] = *(const LAS bf16x8*)(bufp + SB_WW + 2048);  vn[1] = MFMA32(F[1], s0, vn[1]); SCHED;
            F[1] = *(const LAS bf16x8*)(bufp + SB_WW + 10240);  vn[0] = MFMA32(F[2], s1, vn[0]); SCHED;
            F[2] = *(const LAS bf16x8*)(bufp + SB_WW + 3072);  vn[1] = MFMA32(F[3], s1, vn[1]); SCHED;
            F[3] = *(const LAS bf16x8*)(bufp + SB_WW + 11264);  o[0] = MFMA32(s0, F[4], zero16()); SCHED;
            F[4] = *(const LAS bf16x8*)(bufp + SB_QP + 2048);  o[1] = MFMA32(s0, F[5], zero16()); SCHED;
            F[5] = *(const LAS bf16x8*)(bufp + SB_QP + 10240);  o[0] = MFMA32(s1, F[6], o[0]); SCHED;
            F[6] = *(const LAS bf16x8*)(bufp + SB_QP + 3072);  o[1] = MFMA32(s1, F[7], o[1]); SCHED;
            F[7] = *(const LAS bf16x8*)(bufp + SB_QP + 11264); s0 = pack8(S[1], 0); s1 = pack8(S[1], 1); vn[0] = MFMA32(F[0], s0, vn[0]); SCHED;
            F[0] = *(const LAS bf16x8*)(bufp + SB_WW + 4096);  vn[1] = MFMA32(F[1], s0, vn[1]); SCHED;
            F[1] = *(const LAS bf16x8*)(bufp + SB_WW + 12288);  vn[0] = MFMA32(F[2], s1, vn[0]); SCHED;
            F[2] = *(const LAS bf16x8*)(bufp + SB_WW + 5120);  vn[1] = MFMA32(F[3], s1, vn[1]); SCHED;
            F[3] = *(const LAS bf16x8*)(bufp + SB_WW + 13312);  o[0] = MFMA32(s0, F[4], o[0]); SCHED;
            F[4] = *(const LAS bf16x8*)(bufp + SB_QP + 4096);  o[1] = MFMA32(s0, F[5], o[1]); SCHED;
            F[5] = *(const LAS bf16x8*)(bufp + SB_QP + 12288);  o[0] = MFMA32(s1, F[6], o[0]); SCHED;
            F[6] = *(const LAS bf16x8*)(bufp + SB_QP + 5120);  o[1] = MFMA32(s1, F[7], o[1]); SCHED;
            F[7] = *(const LAS bf16x8*)(bufp + SB_QP + 13312); s0 = pack8(S[2], 0); s1 = pack8(S[2], 1); vn[0] = MFMA32(F[0], s0, vn[0]); SCHED;
            F[0] = *(const LAS bf16x8*)(bufp + SB_WW + 6144);  vn[1] = MFMA32(F[1], s0, vn[1]); SCHED;
            F[1] = *(const LAS bf16x8*)(bufp + SB_WW + 14336);  vn[0] = MFMA32(F[2], s1, vn[0]); SCHED;
            F[2] = *(const LAS bf16x8*)(bufp + SB_WW + 7168);  vn[1] = MFMA32(F[3], s1, vn[1]); SCHED;
            F[3] = *(const LAS bf16x8*)(bufp + SB_WW + 15360);  o[0] = MFMA32(s0, F[4], o[0]); SCHED;
            F[4] = *(const LAS bf16x8*)(bufp + SB_QP + 6144);  o[1] = MFMA32(s0, F[5], o[1]); SCHED;
            F[5] = *(const LAS bf16x8*)(bufp + SB_QP + 14336);  o[0] = MFMA32(s1, F[6], o[0]); SCHED;
            F[6] = *(const LAS bf16x8*)(bufp + SB_QP + 7168);  o[1] = MFMA32(s1, F[7], o[1]); SCHED;
            F[7] = *(const LAS bf16x8*)(bufp + SB_QP + 15360); s0 = pack8(S[3], 0); s1 = pack8(S[3], 1); vn[0] = MFMA32(F[0], s0, vn[0]); SCHED;
            F[0] = *(const LAS bf16x8*)(bufp + SB_PP + 4096);  vn[1] = MFMA32(F[1], s0, vn[1]); SCHED;
            F[1] = *(const LAS bf16x8*)(bufp + SB_PP + 0);  vn[0] = MFMA32(F[2], s1, vn[0]); SCHED;
            F[2] = *(const LAS bf16x8*)(bufp + SB_PP + 5120);  vn[1] = MFMA32(F[3], s1, vn[1]); SCHED;
            F[3] = *(const LAS bf16x8*)(bufp + SB_PP + 1024);  o[0] = MFMA32(s0, F[4], o[0]); SCHED;
            F[4] = *(const LAS bf16x8*)(bufp + SB_PP + 6144);  o[1] = MFMA32(s0, F[5], o[1]); SCHED;
            F[5] = *(const LAS bf16x8*)(bufp + SB_PP + 7168);  o[0] = MFMA32(s1, F[6], o[0]); SCHED;
            F[6] = *(const LAS bf16x8*)(bufp + SB_KT + 0);  o[1] = MFMA32(s1, F[7], o[1]); SCHED;
            F[7] = *(const LAS bf16x8*)(bufp + SB_KT + 4096); PACK_V(); o[1] = MFMA32(vbb[0][0], F[0], o[1]); SCHED;
            F[0] = *(const LAS bf16x8*)(bufp + SB_KT + 1024);  o[0] = MFMA32(vbb[0][0], F[1], o[0]); SCHED;
            F[1] = *(const LAS bf16x8*)(bufp + SB_KT + 5120);  o[1] = MFMA32(vbb[0][1], F[2], o[1]); SCHED;
            F[2] = *(const LAS bf16x8*)(bufp + SB_KT + 2048);  o[0] = MFMA32(vbb[0][1], F[3], o[0]); SCHED;
            F[3] = *(const LAS bf16x8*)(bufp + SB_KT + 6144);  o[1] = MFMA32(vbb[1][0], F[4], o[1]); SCHED;
            F[4] = *(const LAS bf16x8*)(bufp + SB_KT + 3072);  o[1] = MFMA32(vbb[1][1], F[5], o[1]); SCHED;
            F[5] = *(const LAS bf16x8*)(bufp + SB_KT + 7168); SCALE_S(); S[0] = MFMA32(F[6], vbb[0][0], S[0]); SCHED;
            F[6] = *(const LAS bf16x8*)(bufp + SB_KT + 8192);  S[1] = MFMA32(F[7], vbb[0][0], S[1]); SCHED;
            F[7] = *(const LAS bf16x8*)(bufp + SB_KT + 12288);  S[0] = MFMA32(F[0], vbb[0][1], S[0]); SCHED;
            F[0] = *(const LAS bf16x8*)(bufp + SB_KT + 9216);  S[1] = MFMA32(F[1], vbb[0][1], S[1]); SCHED;
            F[1] = *(const LAS bf16x8*)(bufp + SB_KT + 13312);  S[0] = MFMA32(F[2], vbb[1][0], S[0]); SCHED;
            F[2] = *(const LAS bf16x8*)(bufp + SB_KT + 10240);  S[1] = MFMA32(F[3], vbb[1][0], S[1]); SCHED;
            F[3] = *(const LAS bf16x8*)(bufp + SB_KT + 14336);  S[0] = MFMA32(F[4], vbb[1][1], S[0]); SCHED;
            F[4] = *(const LAS bf16x8*)(bufp + SB_KT + 11264);  S[1] = MFMA32(F[5], vbb[1][1], S[1]); SCHED;
            STORE_O();
            F[5] = *(const LAS bf16x8*)(bufp + SB_KT + 15360);  S[2] = MFMA32(F[6], vbb[0][0], S[2]); SCHED;
             S[3] = MFMA32(F[7], vbb[0][0], S[3]); SCHED;
             S[2] = MFMA32(F[0], vbb[0][1], S[2]); SCHED;
             S[3] = MFMA32(F[1], vbb[0][1], S[3]); SCHED;
             S[2] = MFMA32(F[2], vbb[1][0], S[2]); SCHED;
             S[3] = MFMA32(F[3], vbb[1][0], S[3]); SCHED;
             S[2] = MFMA32(F[4], vbb[1][1], S[2]); SCHED;
             S[3] = MFMA32(F[5], vbb[1][1], S[3]); SCHED;
        } else {
            F[0] = *(const LAS bf16x8*)(bufp + SB_QP + 0);
            F[1] = *(const LAS bf16x8*)(bufp + SB_QP + 8192);
            F[2] = *(const LAS bf16x8*)(bufp + SB_QP + 1024);
            F[3] = *(const LAS bf16x8*)(bufp + SB_QP + 9216);
            F[4] = *(const LAS bf16x8*)(bufp + SB_QP + 2048);
            F[5] = *(const LAS bf16x8*)(bufp + SB_QP + 10240);
            F[6] = *(const LAS bf16x8*)(bufp + SB_QP + 3072);
            SCHED;
            F[7] = *(const LAS bf16x8*)(bufp + SB_QP + 11264); s0 = pack8(S[0], 0); s1 = pack8(S[0], 1); o[0] = MFMA32(s0, F[0], zero16()); SCHED;
            F[0] = *(const LAS bf16x8*)(bufp + SB_QP + 4096);  o[1] = MFMA32(s0, F[1], zero16()); SCHED;
            F[1] = *(const LAS bf16x8*)(bufp + SB_QP + 12288);  o[0] = MFMA32(s1, F[2], o[0]); SCHED;
            F[2] = *(const LAS bf16x8*)(bufp + SB_QP + 5120);  o[1] = MFMA32(s1, F[3], o[1]); SCHED;
            F[3] = *(const LAS bf16x8*)(bufp + SB_QP + 13312); s0 = pack8(S[1], 0); s1 = pack8(S[1], 1); o[0] = MFMA32(s0, F[4], o[0]); SCHED;
            F[4] = *(const LAS bf16x8*)(bufp + SB_QP + 6144);  o[1] = MFMA32(s0, F[5], o[1]); SCHED;
            F[5] = *(const LAS bf16x8*)(bufp + SB_QP + 14336);  o[0] = MFMA32(s1, F[6], o[0]); SCHED;
            F[6] = *(const LAS bf16x8*)(bufp + SB_QP + 7168);  o[1] = MFMA32(s1, F[7], o[1]); SCHED;
            F[7] = *(const LAS bf16x8*)(bufp + SB_QP + 15360); s0 = pack8(S[2], 0); s1 = pack8(S[2], 1); o[0] = MFMA32(s0, F[0], o[0]); SCHED;
            F[0] = *(const LAS bf16x8*)(bufp + SB_PP + 4096);  o[1] = MFMA32(s0, F[1], o[1]); SCHED;
            F[1] = *(const LAS bf16x8*)(bufp + SB_PP + 0);  o[0] = MFMA32(s1, F[2], o[0]); SCHED;
            F[2] = *(const LAS bf16x8*)(bufp + SB_PP + 5120);  o[1] = MFMA32(s1, F[3], o[1]); SCHED;
            F[3] = *(const LAS bf16x8*)(bufp + SB_PP + 1024); s0 = pack8(S[3], 0); s1 = pack8(S[3], 1); o[0] = MFMA32(s0, F[4], o[0]); SCHED;
            F[4] = *(const LAS bf16x8*)(bufp + SB_PP + 6144);  o[1] = MFMA32(s0, F[5], o[1]); SCHED;
            F[5] = *(const LAS bf16x8*)(bufp + SB_PP + 7168);  o[0] = MFMA32(s1, F[6], o[0]); SCHED;
            F[6] = *(const LAS bf16x8*)(bufp + SB_KT + 0);  o[1] = MFMA32(s1, F[7], o[1]); SCHED;
            F[7] = *(const LAS bf16x8*)(bufp + SB_KT + 4096);  o[1] = MFMA32(vbb[0][0], F[0], o[1]); SCHED;
            F[0] = *(const LAS bf16x8*)(bufp + SB_KT + 1024);  o[0] = MFMA32(vbb[0][0], F[1], o[0]); SCHED;
            F[1] = *(const LAS bf16x8*)(bufp + SB_KT + 5120);  o[1] = MFMA32(vbb[0][1], F[2], o[1]); SCHED;
            F[2] = *(const LAS bf16x8*)(bufp + SB_KT + 2048);  o[0] = MFMA32(vbb[0][1], F[3], o[0]); SCHED;
            F[3] = *(const LAS bf16x8*)(bufp + SB_KT + 6144);  o[1] = MFMA32(vbb[1][0], F[4], o[1]); SCHED;
            F[4] = *(const LAS bf16x8*)(bufp + SB_KT + 3072);  o[1] = MFMA32(vbb[1][1], F[5], o[1]); SCHED;
            F[5] = *(const LAS bf16x8*)(bufp + SB_KT + 7168); SCALE_S(); S[0] = MFMA32(F[6], vbb[0][0], S[0]); SCHED;
            F[6] = *(const LAS bf16x8*)(bufp + SB_KT + 8192);  S[1] = MFMA32(F[7], vbb[0][0], S[1]); SCHED;
            F[7] = *(const LAS bf16x8*)(bufp + SB_KT + 12288);  S[0] = MFMA32(F[0], vbb[0][1], S[0]); SCHED;
            F[0] = *(const LAS bf16x8*)(bufp + SB_KT + 9216);  S[1] = MFMA32(F[1], vbb[0][1], S[1]); SCHED;
            F[1] = *(const LAS bf16x8*)(bufp + SB_KT + 13312);  S[0] = MFMA32(F[2], vbb[1][0], S[0]); SCHED;
            F[2] = *(const LAS bf16x8*)(bufp + SB_KT + 10240);  S[1] = MFMA32(F[3], vbb[1][0], S[1]); SCHED;
            F[3] = *(const LAS bf16x8*)(bufp + SB_KT + 14336);  S[0] = MFMA32(F[4], vbb[1][1], S[0]); SCHED;
            F[4] = *(const LAS bf16x8*)(bufp + SB_KT + 11264);  S[1] = MFMA32(F[5], vbb[1][1], S[1]); SCHED;
            STORE_O();
            F[5] = *(const LAS bf16x8*)(bufp + SB_KT + 15360);  S[2] = MFMA32(F[6], vbb[0][0], S[2]); SCHED;
             S[3] = MFMA32(F[7], vbb[0][0], S[3]); SCHED;
             S[2] = MFMA32(F[0], vbb[0][1], S[2]); SCHED;
             S[3] = MFMA32(F[1], vbb[0][1], S[3]); SCHED;
             S[2] = MFMA32(F[2], vbb[1][0], S[2]); SCHED;
             S[3] = MFMA32(F[3], vbb[1][0], S[3]); SCHED;
             S[2] = MFMA32(F[4], vbb[1][1], S[2]); SCHED;
             S[3] = MFMA32(F[5], vbb[1][1], S[3]); SCHED;
        }
        lds_barrier();
    }
#undef PACK_V
#undef SCALE_S
#undef STORE_O
#undef LD4
#undef LD_W
#undef LD_Q
#undef LD_K
#undef MF_V
#undef MF_O
#undef MF_S
#undef SCHED
}
template <int NT> DI void phase_scan(const Args& a, LAS unsigned char* lds, const int t, const int bid) {
    const int w = __builtin_amdgcn_readfirstlane(t >> 6), lane = t & 63, r = lane & 31, h2 = lane >> 5;
    u16* O = (u16*)(a.ws + WS_O);
    constexpr int PER = 4 / NT, PER2 = 8 / NT, NVB = 32 * PER + 16 * PER2;
    for (int vb = bid; vb < NVB; vb += gridDim.x) {
        int type, bh, cb, g0, colbase, b; size_t ustride; const unsigned char* UUp; const unsigned char* WWp = nullptr;
        if (vb < 32 * PER) { const int y = vb >> 3, x = vb & 7, sub = y % PER; type = 2; bh = (y / PER) * 8 + x; cb = sub * NT; g0 = 1024 + bh * 64; b = bh >> 4; colbase = 2048 + (bh & 15) * 128; ustride = 16384; UUp = a.ws + WS_UU + (size_t)1024 * 32768 + (size_t)(bh * 64) * 16384 + (size_t)cb * 4096; WWp = a.ws + WS_WW + (size_t)(bh * 64) * 16384; }
        else { const int v2 = vb - 32 * PER, y = v2 >> 3, x = v2 & 7, sub = y % PER2, unit = (y / PER2) * 8 + x; type = unit >> 3; bh = unit & 7; cb = sub * NT; g0 = type * 512 + bh * 64; b = bh >> 2; colbase = type * 1024 + (bh & 3) * 256; ustride = 32768; UUp = a.ws + WS_UU + (size_t)g0 * 32768 + (size_t)cb * 4096; }
        const unsigned char* QPp = a.ws + WS_QP + (size_t)g0 * 16384; const unsigned char* PPp = a.ws + WS_PP + (size_t)g0 * 8192; const unsigned char* KTp = a.ws + WS_KT + (size_t)g0 * 16384;
        const unsigned char* DDp = a.ws + WS_DD + (size_t)g0 * 512;
        if (w >= 4) {
            const int tl = t - 256; u32x4 RA[19], RB[19];
#define SCAN_GLOAD(R, n_) do { const int n__ = (n_); \
                { const u32x4* q_ = (const u32x4*)(QPp + (size_t)n__ * 16384) + tl; R[0] = q_[0]; R[1] = q_[256]; R[2] = q_[512]; R[3] = q_[768]; } \
                { const u32x4* q_ = (const u32x4*)(PPp + (size_t)n__ * 8192) + tl; R[4] = q_[0]; R[5] = q_[256]; } \
                { const u32x4* q_ = (const u32x4*)(KTp + (size_t)n__ * 16384) + tl; R[6] = q_[0]; R[7] = q_[256]; R[8] = q_[512]; R[9] = q_[768]; } \
                { const u32x4* q_ = (const u32x4*)(UUp + (size_t)n__ * ustride) + tl; R[10] = q_[0]; if (NT >= 2) R[11] = q_[256]; if (NT == 4) { R[12] = q_[512]; R[13] = q_[768]; } } \
                if (type == 2) { const u32x4* q_ = (const u32x4*)(WWp + (size_t)n__ * 16384) + tl; R[14] = q_[0]; R[15] = q_[256]; R[16] = q_[512]; R[17] = q_[768]; } \
                if (tl < 32) R[18] = ((const u32x4*)(DDp + (size_t)n__ * 512))[tl]; } while (0)
#define SCAN_LSTORE(R, buf_) do { LAS u32x4* d_ = (LAS u32x4*)(lds + (buf_) * SB_SIZE) + tl; \
                d_[SB_QP / 16] = R[0]; d_[SB_QP / 16 + 256] = R[1]; d_[SB_QP / 16 + 512] = R[2]; d_[SB_QP / 16 + 768] = R[3]; \
                d_[SB_PP / 16] = R[4]; d_[SB_PP / 16 + 256] = R[5]; \
                d_[SB_KT / 16] = R[6]; d_[SB_KT / 16 + 256] = R[7]; d_[SB_KT / 16 + 512] = R[8]; d_[SB_KT / 16 + 768] = R[9]; \
                d_[SB_UU / 16] = R[10]; if (NT >= 2) d_[SB_UU / 16 + 256] = R[11]; if (NT == 4) { d_[SB_UU / 16 + 512] = R[12]; d_[SB_UU / 16 + 768] = R[13]; } \
                if (type == 2) { d_[SB_WW / 16] = R[14]; d_[SB_WW / 16 + 256] = R[15]; d_[SB_WW / 16 + 512] = R[16]; d_[SB_WW / 16 + 768] = R[17]; } \
                if (tl < 32) d_[SB_DD / 16] = R[18]; } while (0)
            SCAN_GLOAD(RA, 0); SCAN_LSTORE(RA, 0); SCAN_GLOAD(RA, 1); SCAN_GLOAD(RB, 2);
            lds_barrier();
            for (int n = 0; n < 64; n += 2) {
                SCAN_LSTORE(RA, 1); if (n + 3 < 64) SCAN_GLOAD(RA, n + 3);
                lds_barrier();
                if (n + 2 < 64) { SCAN_LSTORE(RB, 0); if (n + 4 < 64) SCAN_GLOAD(RB, n + 4); }
                lds_barrier();
            }
#undef SCAN_GLOAD
#undef SCAN_LSTORE
        } else if (w >= NT) {
            lds_barrier();
            for (int n = 0; n < 64; ++n) lds_barrier();
        } else {
            u16* Ob = O + (size_t)(b * SEQ) * DM + colbase + 32 * (cb + w);
            if (type == 2) scan_compute<true, false>(lds, Ob, w, lane); else if (type == 1) scan_compute<false, true>(lds, Ob, w, lane); else scan_compute<false, false>(lds, Ob, w, lane);
        }
    }
}

DI void phase_norm(const Args& a, int l, const int t, const int bid) {
    const int w = t >> 6, lane = t & 63;
    const u16* O = (const u16*)(a.ws + WS_O); const u16* PROJ = (const u16*)(a.ws + WS_PROJ); u16* MIX = (u16*)(a.ws + WS_MIX);
    for (int row = bid * 8 + w; row < TOK; row += gridDim.x * 8) {
        const u16* orow = O + (size_t)row * DM; const u16* prow = PROJ + (size_t)row * NPJ;
#pragma unroll
        for (int seg = 0; seg < 8; ++seg) {
            const int c = seg * 512 + lane * 8; const u32x4 ov = __builtin_nontemporal_load((const u32x4*)(orow + c));
            float v[8];
#pragma unroll
            for (int q = 0; q < 4; ++q) { v[2 * q] = bflo(ov[q]); v[2 * q + 1] = bfhi(ov[q]); }
            const float* gp; int gcol; float sc;
            if (seg < 2) { float s = 0.f;
#pragma unroll
                for (int q = 0; q < 8; ++q) s += v[q];
                const float mu = wsum32(s) * (1.f / 256.f); float s2 = 0.f;
#pragma unroll
                for (int q = 0; q < 8; ++q) { v[q] -= mu; s2 += v[q] * v[q]; }
                sc = __builtin_amdgcn_rsqf(wsum32(s2) * (1.f / 256.f) + HEPS); gp = a.ret_g + l * 1024 + c; gcol = 2048 + c; }
            else { float s2 = 0.f;
#pragma unroll
                for (int q = 0; q < 8; ++q) s2 += v[q] * v[q];
                if (seg < 4) { sc = __builtin_amdgcn_rsqf(wsum32(s2) * (1.f / 256.f) + HEPS); gp = a.gla_g + l * 1024 + (c - 1024); gcol = 5120 + (c - 1024); }
                else { sc = __builtin_amdgcn_rsqf(row_sum16(s2) * (1.f / 128.f) + HEPS); gp = a.dn_g + l * 2048 + (c - 2048); gcol = 12288 + (c - 2048); } }
            const f32x4 g0 = *(const f32x4*)gp, g1 = *(const f32x4*)(gp + 4); const u32x4 gt = __builtin_nontemporal_load((const u32x4*)(prow + gcol));
            float y[8];
#pragma unroll
            for (int q = 0; q < 4; ++q) { y[2 * q] = v[2 * q] * sc * (q < 2 ? g0[2 * q] : g1[2 * q - 4]) * silu(bflo(gt[q])); y[2 * q + 1] = v[2 * q + 1] * sc * (q < 2 ? g0[2 * q + 1] : g1[2 * q - 3]) * silu(bfhi(gt[q])); }
            u32x4 o = {pk(y[0], y[1]), pk(y[2], y[3]), pk(y[4], y[5]), pk(y[6], y[7])};
            *(u32x4*)(MIX + (size_t)row * DM + c) = o;
        }
    }
}

DI void phase_ln(const Args& a, int l, const int t, const int bid) {
    const int w = t >> 6, lane = t & 63;
    const u16* Z = (const u16*)(a.ws + WS_Z); u16* XH = (u16*)(a.ws + WS_XF); u16* XB = (u16*)(a.ws + WS_XB);
    const float* G = a.ln_g + l * DM; const float* Bv = a.ln_b + l * DM;
    for (int row = bid * 8 + w; row < TOK; row += gridDim.x * 8) {
        float v[8][8]; float s = 0.f;
#pragma unroll
        for (int q = 0; q < 8; ++q) { const u32x4 zv = __builtin_nontemporal_load((const u32x4*)(Z + (size_t)row * DM + q * 512 + lane * 8));
#pragma unroll
            for (int j = 0; j < 4; ++j) { v[q][2 * j] = hlo(zv[j]); v[q][2 * j + 1] = hhi(zv[j]); s += v[q][2 * j] + v[q][2 * j + 1]; } }
        const float mu = wsum64(s) * (1.f / 4096.f); float s2 = 0.f;
#pragma unroll
        for (int q = 0; q < 8; ++q)
#pragma unroll
            for (int j = 0; j < 8; ++j) { v[q][j] -= mu; s2 += v[q][j] * v[q][j]; }
        const float rstd = __builtin_amdgcn_rsqf(wsum64(s2) * (1.f / 4096.f) + LNEPS);
#pragma unroll
        for (int q = 0; q < 8; ++q) { const int c = q * 512 + lane * 8; const f32x4 g0 = *(const f32x4*)(G + c), g1 = *(const f32x4*)(G + c + 4), b0 = *(const f32x4*)(Bv + c), b1 = *(const f32x4*)(Bv + c + 4);
            f32x4 y0, y1;
#pragma unroll
            for (int j = 0; j < 4; ++j) { y0[j] = v[q][j] * rstd * g0[j] + b0[j]; y1[j] = v[q][4 + j] * rstd * g1[j] + b1[j]; }
            if (l == 1) { *(f32x4*)(a.out + (size_t)row * DM + c) = y0; *(f32x4*)(a.out + (size_t)row * DM + c + 4) = y1; }
            else { u32x4 oh = {pkh(y0[0], y0[1]), pkh(y0[2], y0[3]), pkh(y1[0], y1[1]), pkh(y1[2], y1[3])}; *(u32x4*)(XH + (size_t)row * DM + c) = oh;
                   u32x4 ob = {pk(y0[0], y0[1]), pk(y0[2], y0[3]), pk(y1[0], y1[1]), pk(y1[2], y1[3])}; *(u32x4*)(XB + (size_t)row * DM + c) = ob; } }
    }
}

__global__ void __launch_bounds__(512, 2) hybrid_fwd(Args a) {
    extern __shared__ __attribute__((aligned(16))) unsigned char smem[];
    cg::grid_group grid = cg::this_grid();
    LAS float* ldsf = (LAS float*)smem;
    volatile LAS unsigned* xst = (volatile LAS unsigned*)(smem + LDS_BYTES - 16);
    if (threadIdx.x == 0) { xst[0] = 0u; xst[1] = 0u; }
    __syncthreads();
    const XcdBarrier xbar = xcd_barrier_post((unsigned*)(a.ws + WS_BAR), xst);
    for (int ph = a.ph_lo; ph < a.ph_hi; ++ph) {
        if (ph > a.ph_lo) { if (a.ph_hi > NPHASE) grid.sync();
            xcd_barrier(xbar); }
        int tid = threadIdx.x, bid = blockIdx.x; asm volatile("" : "+v"(tid)); asm volatile("" : "+s"(bid));
        if (ph == 0) {
#ifndef NO_CONV
 for (int rep = 0; rep < REP_CONV; ++rep) { phase_convert(a, ldsf, tid, bid, gridDim.x, 0, gridDim.x >= 256 ? 18688 : 2 * 18688, true); __syncthreads(); }
#endif
 continue; }
        const int l = (ph - 1) / 6, sub = (ph - 1) % 6;
        if (sub == 0) {
#ifndef NO_G1
            pg8::Gemm g; g.A = (const pg8::bf16_t*)(a.ws + WS_XB); g.Bt = (const pg8::bf16_t*)(a.ws + WS_WIN) + (size_t)l * NPAD * 4096; g.M = TOK; g.N = NPJ; g.K = 4096;
            pg8::StaticOrder so; so.init(TOK, NPJ, gridDim.x, bid);
            EpiProj e; e.O = (u16*)(a.ws + WS_PROJ);
            for (int rep = 0; rep < REP_G1; ++rep) { pg8::gemm_phase<EpiProj, pg8::StaticOrder, false>((LAS unsigned char*)smem, g, so, e, nullptr, tid);
            __syncthreads(); }
            phase_skinny(a, l, ldsf, tid, bid);
#endif
        } else if (sub == 1) {
#ifndef NO_PREP
 for (int rep = 0; rep < REP_PREP; ++rep) { phase_prep(a, l, ldsf, tid, bid); __syncthreads(); }
#endif
 }
        else if (sub == 2) {
#ifndef NO_SCAN
 for (int rep = 0; rep < REP_SCAN; ++rep) { if (gridDim.x < 256) phase_scan<4>(a, (LAS unsigned char*)smem, tid, bid); else if (l == 0) phase_scan<2>(a, (LAS unsigned char*)smem, tid, bid); else phase_scan<1>(a, (LAS unsigned char*)smem, tid, bid); __syncthreads(); }
            if (gridDim.x >= 256 && l == 0 && bid >= 128) phase_convert(a, ldsf, tid, bid - 128, gridDim.x - 128, 18688, 2 * 18688, false);
#endif
 }
        else if (sub == 3) {
#ifndef NO_NORM
 for (int rep = 0; rep < REP_NORM; ++rep) phase_norm(a, l, tid, bid);
#endif
 }
        else if (sub == 4) {
#ifndef NO_G2
            pg8::Gemm g; g.A = (const pg8::bf16_t*)(a.ws + WS_MIX); g.Bt = (const pg8::bf16_t*)(a.ws + WS_WOUT) + (size_t)l * 4096 * 4096; g.M = TOK; g.N = DM; g.K = 4096;
            pg8::StaticOrder so; so.init(TOK, DM, gridDim.x, bid);
            EpiZ e; e.Z = (u16*)(a.ws + WS_Z); e.X = (l == 0) ? a.x : nullptr; e.XH = (const u16*)(a.ws + WS_XF);
            for (int rep = 0; rep < REP_G2; ++rep) { pg8::gemm_phase<EpiZ, pg8::StaticOrder, false>((LAS unsigned char*)smem, g, so, e, nullptr, tid);
            __syncthreads(); }
#endif
        } else {
#ifndef NO_LN
 for (int rep = 0; rep < REP_LN; ++rep) phase_ln(a, l, tid, bid);
#endif
 }
    }
}

extern "C" void kernel_launch(void* const* d_in, const int* in_sizes, int n_in, void* d_out, int out_size, void* d_ws, size_t ws_size, hipStream_t stream) {
    static int grid = 0;
    if (grid == 0) {
        if (n_in != 14 || ws_size < WS_END) { fprintf(stderr, "kernel_launch: unexpected inputs (n_in %d, ws %zu < %zu)\n", n_in, ws_size, (size_t)WS_END); grid = -1; return; }
        int dev = 0, cus = 0, per_cu = 0;
        hipGetDevice(&dev); hipDeviceGetAttribute(&cus, hipDeviceAttributeMultiprocessorCount, dev);
        if (hipFuncSetAttribute((const void*)hybrid_fwd, hipFuncAttributeMaxDynamicSharedMemorySize, LDS_BYTES) != hipSuccess) { fprintf(stderr, "kernel_launch: hipFuncSetAttribute failed\n"); grid = -1; return; }
        if (hipOccupancyMaxActiveBlocksPerMultiprocessor(&per_cu, (const void*)hybrid_fwd, 512, LDS_BYTES) != hipSuccess || per_cu < 1) { fprintf(stderr, "kernel_launch: occupancy query says %d\n", per_cu); per_cu = 1; }
        (void)hipGetLastError();
        grid = cus * 1;
        if (grid < 64) { fprintf(stderr, "kernel_launch: grid %d too small\n", grid); grid = -1; return; }
    }
    if (grid < 0) return;
    Args a{};
    a.x = (const float*)d_in[0]; a.pos = (const int*)d_in[1]; a.w_in = (const float*)d_in[2]; a.w_a2 = (const float*)d_in[3]; a.b_a = (const float*)d_in[4]; a.conv_w = (const float*)d_in[5];
    a.a_log = (const float*)d_in[6]; a.dt_bias = (const float*)d_in[7]; a.ret_g = (const float*)d_in[8]; a.gla_g = (const float*)d_in[9]; a.dn_g = (const float*)d_in[10];
    a.w_out = (const float*)d_in[11]; a.ln_g = (const float*)d_in[12]; a.ln_b = (const float*)d_in[13];
    a.out = (float*)d_out; a.ws = (unsigned char*)d_ws; a.ph_lo = 0; a.ph_hi = NPHASE;
    if (hipMemsetAsync((unsigned char*)d_ws + WS_BAR, 0, 16384, stream) != hipSuccess) { fprintf(stderr, "kernel_launch: memset of the barrier words failed\n"); return; }
    void* args[] = {&a};
    hipError_t e = hipLaunchCooperativeKernel((const void*)hybrid_fwd, dim3(grid), dim3(512), args, LDS_BYTES, stream);
    if (e != hipSuccess) fprintf(stderr, "kernel_launch: cooperative launch failed: %s (grid %d)\n", hipGetErrorString(e), grid);
}
```

```cpp
#include <hip/hip_runtime.h>
#include <hip/hip_cooperative_groups.h>
#include <cstdio>
namespace cg = cooperative_groups;
namespace pg8 {
#define PG8_LAS __attribute__((address_space(3)))
typedef unsigned short bf16_t;
typedef short bf16x8 __attribute__((ext_vector_type(8)));
typedef float f32x4 __attribute__((ext_vector_type(4)));
typedef unsigned u32x4 __attribute__((ext_vector_type(4)));
constexpr int BM = 256, BK = 64, HALF = 128, HTB = HALF * BK * 2  , STAGE_BYTES = 8 * HTB, NXCD = 8, WGM = 4;

__host__ __device__ __forceinline__ int lds_byte(int r, int c) { const int st = (r >> 4) * 2 + (c >> 5), rr = r & 15, cc = c & 31, ob = rr * 64 + cc * 2; return st * 1024 + (ob ^ (((ob >> 9) & 1) << 5)); }
__host__ __device__ __forceinline__ void stage_rc(int b, int& R, int& C) { const int st = b / 1024, sb = b % 1024, swz = sb ^ (((sb >> 9) & 1) << 5); R = (st >> 1) * 16 + swz / 64; C = (st & 1) * 32 + (swz % 64) / 2; }
__host__ __device__ __forceinline__ int perm32(int rho) { const int n = rho >> 4, i = rho & 15; return 8 * (i >> 2) + 4 * n + (i & 3); }

struct Unit { int pm, pn; };
struct Gemm { const bf16_t* A; const bf16_t* Bt; int M, N, K; };

struct StaticOrder {
    int nM, nN, nwg, G, c;
    __host__ __device__ void init(int M, int N, int G_, int c_) { nM = M / BM; nN = N / BM; nwg = nM * nN; G = G_; c = c_; }
    __host__ __device__ bool next(int i, Unit& u) const {
        const long L = (long)i * G + c; if (L >= nwg) return false;
        int wgid = (int)L; { const int q = nwg / NXCD, r = nwg % NXCD, xcd = wgid % NXCD, off = wgid / NXCD; wgid = (xcd < r ? xcd * (q + 1) : r * (q + 1) + (xcd - r) * q) + off; }
        const int nig = WGM * nN, gid = wgid / nig, fm = gid * WGM, gsz = (nM - fm) < WGM ? (nM - fm) : WGM;
        u.pm = fm + ((wgid % nig) % gsz); u.pn = (wgid % nig) / gsz; return true;
    }
    __device__ __forceinline__ void a_ready(const Unit&) const {}
    __device__ __forceinline__ void done(const Unit&) const {}
};
template <class Epi, class Sched, bool STAMP = false>
__device__ __forceinline__ void gemm_phase(PG8_LAS unsigned char* lds, const Gemm g, const Sched& S, const Epi& E, unsigned long long* stamps, const int tid_in) {
    const int tid = tid_in, wid = __builtin_amdgcn_readfirstlane(tid >> 6), lane = tid & 63, wr = wid >> 2, wc = wid & 3, fr = lane & 15, fq = lane >> 4;
    const int K = g.K, nt = K / BK;
    int ts_lo = 0, ts_hi = 0, nts = 0; const unsigned long long rt_entry = STAMP ? (unsigned long long)wall_clock64() : 0ull;
#define PG8_STAMP() do { if (STAMP && wid == 0 && nts < 64) { const unsigned long long _c = (unsigned long long)clock64(); \
        ts_lo = (lane == nts) ? (int)(unsigned)_c : ts_lo; ts_hi = (lane == nts) ? (int)(unsigned)(_c >> 32) : ts_hi; ++nts; } } while (0)
    PG8_STAMP();
    unsigned voffA[2], voffB[2];
#pragma unroll
    for (int i = 0; i < 2; ++i) { int R, C; stage_rc(tid * 16 + i * 8192, R, C); const int Rb = Epi::PERM ? ((R & ~31) + perm32(R & 31)) : R;
        voffA[i] = (unsigned)(R * K + C) * 2u; voffB[i] = (unsigned)(Rb * K + C) * 2u; }
    const size_t kstep = (size_t)(BK * 2);
    const size_t hstep = (size_t)HALF * K * 2;
    const size_t tstep = 2 * hstep;
    const unsigned ldsw = (unsigned)wid * 1024u;
    const int aoff = lds_byte(wr * 64 + fr, fq * 8), boff = lds_byte(wc * 32 + fr, fq * 8);
#define PG8_SA(b, h) (((b) * 2 + (h)) * HTB)
#define PG8_SB(b, h) ((4 + (b) * 2 + (h)) * HTB)
#define PG8_STAGE(bufoff, gbase, voff) do { _Pragma("unroll") for (int _i = 0; _i < 2; ++_i) \
        __builtin_amdgcn_global_load_lds((const unsigned*)((const char*)(gbase) + (voff)[_i]), (PG8_LAS unsigned*)(lds + (bufoff) + ldsw + _i * 8192), 16, 0, 0); } while (0)
#define PG8_LDA(dst, b, h) do { _Pragma("unroll") for (int m = 0; m < 4; ++m) _Pragma("unroll") for (int k = 0; k < 2; ++k) dst[m][k] = *(const PG8_LAS bf16x8*)(lds + PG8_SA(b, h) + aoff + m * 2048 + k * 1024); } while (0)
#define PG8_LDB(dst, b, h) do { _Pragma("unroll") for (int n = 0; n < 2; ++n) _Pragma("unroll") for (int k = 0; k < 2; ++k) dst[n][k] = *(const PG8_LAS bf16x8*)(lds + PG8_SB(b, h) + boff + n * 2048 + k * 1024); } while (0)
#define PG8_MMA(ai, bj, At, Bt) do { __builtin_amdgcn_s_setprio(1); _Pragma("unroll") for (int m = 0; m < 4; ++m) _Pragma("unroll") for (int n = 0; n < 2; ++n) _Pragma("unroll") for (int k = 0; k < 2; ++k) \
        acc[ai][bj][m][n] = __builtin_amdgcn_mfma_f32_16x16x32_bf16(Bt[n][k], At[m][k], acc[ai][bj][m][n], 0, 0, 0); __builtin_amdgcn_s_setprio(0); } while (0)
#define PG8_WAIT_V(n) asm volatile("s_waitcnt vmcnt(" #n ")" ::: "memory")
#define PG8_WAIT_L(n) asm volatile("s_waitcnt lgkmcnt(" #n ")" ::: "memory")
#define PG8_BAR __builtin_amdgcn_s_barrier()
#define PG8_SCHED __builtin_amdgcn_sched_barrier(0)
    Unit cur, nxt; int ui = 0;
    if (!S.next(0, cur)) return;
    f32x4 acc[2][2][4][2];
#pragma unroll
    for (int a = 0; a < 2; ++a)
#pragma unroll
        for (int b = 0; b < 2; ++b)
#pragma unroll
            for (int m = 0; m < 4; ++m)
#pragma unroll
                for (int n = 0; n < 2; ++n) acc[a][b][m][n] = (f32x4){0.f, 0.f, 0.f, 0.f};
    bf16x8 At[4][2], B0[2][2], B1[2][2];
    const char* cA = (const char*)g.A + (size_t)cur.pm * tstep; const char* cB = (const char*)g.Bt + (size_t)cur.pn * tstep;
    S.a_ready(cur);
    PG8_STAGE(PG8_SB(0, 0), cB, voffB); PG8_STAGE(PG8_SA(0, 0), cA, voffA); PG8_STAGE(PG8_SB(0, 1), cB + hstep, voffB); PG8_STAGE(PG8_SA(0, 1), cA + hstep, voffA);
    if (wr == 1) PG8_BAR;
    PG8_WAIT_V(4); PG8_BAR;
    PG8_STAGE(PG8_SB(1, 0), cB + kstep, voffB); PG8_STAGE(PG8_SA(1, 0), cA + kstep, voffA); PG8_STAGE(PG8_SB(1, 1), cB + hstep + kstep, voffB);
    PG8_WAIT_V(6); PG8_BAR;
    PG8_STAMP();
    for (;;) {
        const bool has_next = S.next(ui + 1, nxt);
        const char* nA = has_next ? (const char*)g.A + (size_t)nxt.pm * tstep : cA; const char* nB = has_next ? (const char*)g.Bt + (size_t)nxt.pn * tstep : cB;
        for (int t = 0; t < nt; t += 2) {
            const bool last = (t == nt - 2);
            const char* a1 = cA + (size_t)(t + 1) * kstep;
            const char* a2 = last ? nA : cA + (size_t)(t + 2) * kstep; const char* b2 = last ? nB : cB + (size_t)(t + 2) * kstep;
            const char* a3 = a2 + kstep; const char* b3 = b2 + kstep;
            if (last && has_next) S.a_ready(nxt);
            PG8_LDB(B0, 0, 0); PG8_SCHED; PG8_LDA(At, 0, 0); PG8_STAGE(PG8_SA(1, 1), a1 + hstep, voffA);
            PG8_WAIT_L(8); PG8_BAR; PG8_WAIT_L(0); PG8_MMA(0, 0, At, B0); PG8_BAR; PG8_SCHED;
            PG8_LDB(B1, 0, 1); PG8_STAGE(PG8_SB(0, 0), b2, voffB);
            PG8_BAR; PG8_WAIT_L(0); PG8_MMA(0, 1, At, B1); PG8_BAR;
            PG8_LDA(At, 0, 1); PG8_STAGE(PG8_SA(0, 0), a2, voffA);
            PG8_BAR; PG8_WAIT_L(0); PG8_MMA(1, 0, At, B0); PG8_BAR; PG8_SCHED;
            PG8_STAGE(PG8_SB(0, 1), b2 + hstep, voffB);
            PG8_WAIT_V(6); PG8_BAR; PG8_MMA(1, 1, At, B1); PG8_BAR;
            PG8_LDB(B0, 1, 0); PG8_SCHED; PG8_LDA(At, 1, 0); PG8_STAGE(PG8_SA(0, 1), a2 + hstep, voffA);
            PG8_WAIT_L(8); PG8_BAR; PG8_WAIT_L(0); PG8_MMA(0, 0, At, B0); PG8_BAR; PG8_SCHED;
            PG8_LDB(B1, 1, 1); PG8_STAGE(PG8_SB(1, 0), b3, voffB);
            PG8_BAR; PG8_WAIT_L(0); PG8_MMA(0, 1, At, B1); PG8_BAR;
            PG8_LDA(At, 1, 1); PG8_STAGE(PG8_SA(1, 0), a3, voffA);
            PG8_BAR; PG8_WAIT_L(0); PG8_MMA(1, 0, At, B0); PG8_BAR; PG8_SCHED;
            PG8_STAGE(PG8_SB(1, 1), b3 + hstep, voffB);
            PG8_WAIT_V(6); PG8_BAR; PG8_MMA(1, 1, At, B1); PG8_BAR;
        }
        PG8_STAMP();
        if constexpr (!Epi::AFTER_DRAIN) { E(acc, cur, wr, wc, fr, fq); S.done(cur); }
        PG8_STAMP();
        if (!has_next) break;
#pragma unroll
        for (int a = 0; a < 2; ++a)
#pragma unroll
            for (int b = 0; b < 2; ++b)
#pragma unroll
                for (int m = 0; m < 4; ++m)
#pragma unroll
                    for (int n = 0; n < 2; ++n) acc[a][b][m][n] = (f32x4){0.f, 0.f, 0.f, 0.f};
        cur = nxt; cA = nA; cB = nB; ++ui;
    }
    PG8_WAIT_V(0);
    if (wr == 0) PG8_BAR;
    PG8_BAR;
    if constexpr (Epi::AFTER_DRAIN) { E.fused(acc, cur, wr, wc, fr, fq, lds, wid, lane); S.done(cur); }
    PG8_STAMP();
    if (STAMP && wid == 0) { stamps[lane] = lane < nts ? (((unsigned long long)(unsigned)ts_hi << 32) | (unsigned)ts_lo) : 0ull;
        if (lane == 62) stamps[62] = rt_entry; if (lane == 63) stamps[63] = (unsigned long long)wall_clock64(); }
#undef PG8_STAMP
#undef PG8_SA
#undef PG8_SB
#undef PG8_STAGE
#undef PG8_LDA
#undef PG8_LDB
#undef PG8_MMA
#undef PG8_WAIT_V
#undef PG8_WAIT_L
#undef PG8_BAR
#undef PG8_SCHED
}
}

#define DI __device__ __forceinline__
#define LAS __attribute__((address_space(3)))
typedef unsigned short u16;
typedef pg8::bf16x8 bf16x8;
typedef pg8::f32x4 f32x4;
typedef pg8::u32x4 u32x4;
typedef float f32x16 __attribute__((ext_vector_type(16)));
typedef unsigned u32x2 __attribute__((ext_vector_type(2)));
typedef __bf16 bf16v2 __attribute__((ext_vector_type(2)));
typedef float f32x2 __attribute__((ext_vector_type(2)));
#define MFMA32(a, b, c) __builtin_amdgcn_mfma_f32_32x32x16_bf16((a), (b), (c), 0, 0, 0)

constexpr int TOK = 8192, SEQ = 4096, DM = 4096, NPAD = 14592, NPJ = 14336, DIN = 14384;
constexpr float ALPHA = 1.4142135623730951f;
constexpr float HEPS = 1e-6f, LNEPS = 1e-5f;
constexpr float QSCALE = 0.08838834764831845f;
constexpr size_t WS_WIN = 0;
constexpr size_t WS_WOUT = WS_WIN + (size_t)2 * NPAD * 4096 * 2;
constexpr size_t WS_XB = WS_WOUT + (size_t)2 * 4096 * 4096 * 2;
constexpr size_t WS_XF = WS_XB + (size_t)TOK * DM * 2;
constexpr size_t WS_PROJ = WS_XF + (size_t)TOK * DM * 4;
constexpr size_t WS_PROJS = WS_PROJ + (size_t)TOK * NPJ * 2;
constexpr size_t WS_QP = WS_PROJS + (size_t)TOK * 64 * 4;
constexpr size_t WS_PP = WS_QP + (size_t)3072 * 16384;
constexpr size_t WS_KT = WS_PP + (size_t)3072 * 8192;
constexpr size_t WS_WW = WS_KT + (size_t)3072 * 16384;
constexpr size_t WS_DD = WS_WW + (size_t)2048 * 16384;
constexpr size_t WS_UU = WS_DD + (size_t)3072 * 512;
constexpr size_t WS_O = WS_UU + (size_t)1024 * 32768 + (size_t)2048 * 16384;
constexpr size_t WS_MIX = WS_O + (size_t)TOK * DM * 4;
constexpr size_t WS_Z = WS_MIX + (size_t)TOK * DM * 2;
constexpr size_t WS_BAR = WS_Z + (size_t)TOK * DM * 4;
constexpr size_t WS_END = WS_BAR + 16384;
constexpr int LDS_BYTES = 163840;
constexpr int NPHASE = 13;
#ifndef REPS
#define REPS 1,1,1,1,1,1,1
#endif
constexpr int REP_ARR[7] = {REPS};
constexpr int REP_CONV = REP_ARR[0], REP_G1 = REP_ARR[1], REP_PREP = REP_ARR[2], REP_SCAN = REP_ARR[3], REP_NORM = REP_ARR[4], REP_G2 = REP_ARR[5], REP_LN = REP_ARR[6];

struct Args {
    const float* x; const int* pos; const float* w_in; const float* w_a2; const float* b_a; const float* conv_w; const float* a_log; const float* dt_bias;
    const float* ret_g; const float* gla_g; const float* dn_g; const float* w_out; const float* ln_g; const float* ln_b;
    float* out; unsigned char* ws; int ph_lo, ph_hi;
};

DI unsigned pk(float lo, float hi) { f32x2 v = {lo, hi}; bf16v2 r = __builtin_convertvector(v, bf16v2); return __builtin_bit_cast(unsigned, r); }
typedef _Float16 f16x2 __attribute__((ext_vector_type(2)));
DI unsigned pkh(float lo, float hi) { f16x2 r = {(_Float16)lo, (_Float16)hi}; return __builtin_bit_cast(unsigned, r); }
DI float hlo(unsigned u) { return (float)__builtin_bit_cast(f16x2, u)[0]; }
DI float hhi(unsigned u) { return (float)__builtin_bit_cast(f16x2, u)[1]; }
DI float bf2f(u16 v) { return __uint_as_float((unsigned)v << 16); }
DI float bflo(unsigned u) { return __uint_as_float(u << 16); }
DI float bfhi(unsigned u) { return __uint_as_float(u & 0xffff0000u); }
DI int crow(int reg, int h) { return (reg & 3) + 8 * (reg >> 2) + 4 * h; }
DI f32x16 zero16() { f32x16 z;
#pragma unroll
    for (int i = 0; i < 16; ++i) z[i] = 0.f; return z; }
DI u32x4 pack8u(const f32x16& x, const int s) { u32x4 p = {pk(x[8 * s], x[8 * s + 1]), pk(x[8 * s + 2], x[8 * s + 3]), pk(x[8 * s + 4], x[8 * s + 5]), pk(x[8 * s + 6], x[8 * s + 7])}; return p; }
DI bf16x8 pack8(const f32x16& x, const int s) { return __builtin_bit_cast(bf16x8, pack8u(x, s)); }
DI bf16x8 ld_nat(const LAS float* p) { const f32x4 a = *(const LAS f32x4*)p; const f32x4 b = *(const LAS f32x4*)(p + 4);
    u32x4 r = {pk(a[0], a[1]), pk(a[2], a[3]), pk(b[0], b[1]), pk(b[2], b[3])}; return __builtin_bit_cast(bf16x8, r); }
DI bf16x8 ld_tr(const LAS float* p, const int ld) { u32x4 r = {pk(p[0], p[ld]), pk(p[2 * ld], p[3 * ld]), pk(p[4 * ld], p[5 * ld]), pk(p[6 * ld], p[7 * ld])}; return __builtin_bit_cast(bf16x8, r); }
template <int CTRL> DI float dpp_add(float x) { return x + __int_as_float(__builtin_amdgcn_update_dpp(0, __float_as_int(x), CTRL, 0xf, 0xf, true)); }
DI float row_sum16(float x) { x = dpp_add<0xB1>(x); x = dpp_add<0x4E>(x); x = dpp_add<0x141>(x); x = dpp_add<0x140>(x); return x; }
DI float rdl(float x, int l) { return __int_as_float(__builtin_amdgcn_readlane(__float_as_int(x), l)); }
DI float wsum64(float v) { v = row_sum16(v); return (rdl(v, 0) + rdl(v, 16)) + (rdl(v, 32) + rdl(v, 48)); }
DI void wsum64x8(float (&v)[8]) {
#pragma unroll
    for (int i = 0; i < 8; ++i) v[i] = dpp_add<0xB1>(v[i]);
#pragma unroll
    for (int i = 0; i < 8; ++i) v[i] = dpp_add<0x4E>(v[i]);
#pragma unroll
    for (int i = 0; i < 8; ++i) v[i] = dpp_add<0x141>(v[i]);
#pragma unroll
    for (int i = 0; i < 8; ++i) v[i] = dpp_add<0x140>(v[i]);
#pragma unroll
    for (int i = 0; i < 8; ++i) v[i] = (rdl(v[i], 0) + rdl(v[i], 16)) + (rdl(v[i], 32) + rdl(v[i], 48));
}
DI float wsum32(float v) { v = row_sum16(v); const float lo = rdl(v, 0) + rdl(v, 16), hi = rdl(v, 32) + rdl(v, 48); return (threadIdx.x & 32) ? hi : lo; }
DI void lds_barrier() { asm volatile("s_waitcnt lgkmcnt(0)" ::: "memory"); __builtin_amdgcn_s_barrier(); asm volatile("" ::: "memory"); }
DI float silu(float y) { return y * __builtin_amdgcn_rcpf(1.f + __expf(-y)); }
DI float softplus(float x) { return fmaxf(x, 0.f) + __logf(1.f + __expf(-fabsf(x))); }

struct EpiProj {
    static constexpr bool PERM = true, AFTER_DRAIN = false;
    u16* O;
    DI void operator()(const f32x4 (&acc)[2][2][4][2], const pg8::Unit& u, int wr, int wc, int fr, int fq) const {
        const int row0 = u.pm * 256 + wr * 64 + fr;
        const int col0 = u.pn * 256 + wc * 32 + 8 * fq;
#pragma unroll
        for (int ai = 0; ai < 2; ++ai)
#pragma unroll
            for (int m = 0; m < 4; ++m) { u16* rowp = O + (size_t)(row0 + ai * 128 + m * 16) * NPJ + col0;
#pragma unroll
                for (int bj = 0; bj < 2; ++bj) { const f32x4 v0 = acc[ai][bj][m][0], v1 = acc[ai][bj][m][1];
                    u32x4 o = {pk(v0[0], v0[1]), pk(v0[2], v0[3]), pk(v1[0], v1[1]), pk(v1[2], v1[3])}; *(u32x4*)(rowp + bj * 128) = o; } }
    }
};
struct EpiZ {
    static constexpr bool PERM = true, AFTER_DRAIN = false;
    u16* Z; const float* X; const u16* XH;
    DI void operator()(const f32x4 (&acc)[2][2][4][2], const pg8::Unit& u, int wr, int wc, int fr, int fq) const {
        const int row0 = u.pm * 256 + wr * 64 + fr, col0 = u.pn * 256 + wc * 32 + 8 * fq;
#pragma unroll
        for (int ai = 0; ai < 2; ++ai)
#pragma unroll
            for (int m = 0; m < 4; ++m) { const size_t ro = (size_t)(row0 + ai * 128 + m * 16) * DM + col0;
#pragma unroll
                for (int bj = 0; bj < 2; ++bj) { f32x4 x0, x1;
                    if (X) { x0 = *(const f32x4*)(X + ro + bj * 128); x1 = *(const f32x4*)(X + ro + bj * 128 + 4); }
                    else { const u32x4 xb = *(const u32x4*)(XH + ro + bj * 128); x0[0] = hlo(xb[0]); x0[1] = hhi(xb[0]); x0[2] = hlo(xb[1]); x0[3] = hhi(xb[1]); x1[0] = hlo(xb[2]); x1[1] = hhi(xb[2]); x1[2] = hlo(xb[3]); x1[3] = hhi(xb[3]); }
                    const f32x4 z0 = x0 * ALPHA + acc[ai][bj][m][0], z1 = x1 * ALPHA + acc[ai][bj][m][1];
                    u32x4 o = {pkh(z0[0], z0[1]), pkh(z0[2], z0[3]), pkh(z1[0], z1[1]), pkh(z1[2], z1[3])}; *(u32x4*)(Z + ro + bj * 128) = o; } }
    }
};
#define XB_TMO      128
#define XB_XCNT(j)  (256  + 64 * (j))
#define XB_XSUB(j)  (1280 + 64 * (j))
#define XB_XGEN(j)  (2304 + 64 * (j))
#define XB_TOP      3328
#define XB_TOPGEN   3392
#define XCD_BAR_WORDS 3456
#define XB_SPIN_CAP (1u << 18)

__device__ __forceinline__ unsigned xb_ld(unsigned* p)              { return __hip_atomic_load(p, __ATOMIC_RELAXED, __HIP_MEMORY_SCOPE_AGENT); }
__device__ __forceinline__ unsigned xb_add(unsigned* p, unsigned v) { return __hip_atomic_fetch_add(p, v, __ATOMIC_RELAXED, __HIP_MEMORY_SCOPE_AGENT); }
__device__ __forceinline__ unsigned xb_xcc_id() { return (unsigned)__builtin_amdgcn_s_getreg((3 << 11) | 20) & 0xFu; }
#define XB_SPIN(cond, bar) do { unsigned _sp = 0; while (cond) { __builtin_amdgcn_s_sleep(1); \
    if ((++_sp & 255u) == 0u) { if (xb_ld(&(bar)[XB_TMO])) break; if (_sp > XB_SPIN_CAP) { atomicAdd(&(bar)[XB_TMO], 1u); break; } } } } while (0)

struct XcdBarrier {
    unsigned* bar; unsigned x;
    volatile LAS unsigned* st;
};

__device__ __forceinline__ XcdBarrier xcd_barrier_post(unsigned* bar, volatile LAS unsigned* st) {
    XcdBarrier b; b.bar = bar; b.x = xb_xcc_id(); b.st = st;
    if (threadIdx.x == 0) (void)xb_add(&bar[XB_XCNT(b.x)], 1u);
    return b;
}
__device__ __forceinline__ void xcd_barrier_complete(unsigned* bar, unsigned x, unsigned& nloc, unsigned& nx) {
    const unsigned G = gridDim.x * gridDim.y * gridDim.z;
    unsigned sum, cnt, mine, sp = 0u;
    for (;;) {
        sum = 0u; cnt = 0u; mine = 0u;
#pragma unroll
        for (unsigned j = 0; j < 16; ++j) { const unsigned c = xb_ld(&bar[XB_XCNT(j)]); sum += c; cnt += (c > 0u) ? 1u : 0u; mine = (j == x) ? c : mine; }
        if (sum == G) break;
        __builtin_amdgcn_s_sleep(1);
        if ((++sp & 255u) == 0u) { if (xb_ld(&bar[XB_TMO])) break; if (sp > XB_SPIN_CAP) { atomicAdd(&bar[XB_TMO], 1u); break; } }
    }
    nloc = mine > 0u ? mine : 1u; nx = cnt > 0u ? cnt : 1u;
}

__device__ __forceinline__ void xcd_barrier(const XcdBarrier& b) {
    asm volatile("s_waitcnt vmcnt(0)" ::: "memory");
    __syncthreads();
    if (threadIdx.x == 0) {
        unsigned* bar = b.bar;
        __builtin_amdgcn_s_waitcnt(0);
        unsigned nloc = b.st[0], nx = b.st[1];
        if (nloc == 0u) { xcd_barrier_complete(bar, b.x, nloc, nx); b.st[0] = nloc; b.st[1] = nx; }
        const unsigned old = xb_add(&bar[XB_XSUB(b.x)], 1u);
        const unsigned gen = old / nloc;
        if (old + 1u == (gen + 1u) * nloc) {
            __builtin_amdgcn_fence(__ATOMIC_RELEASE, "agent");
            asm volatile("s_waitcnt vmcnt(0)" ::: "memory");
            const unsigned og = xb_add(&bar[XB_TOP], 1u);
            const unsigned tg = og / nx;
            if (og + 1u == (tg + 1u) * nx) xb_add(&bar[XB_TOPGEN], 1u);
            else XB_SPIN(xb_ld(&bar[XB_TOPGEN]) == tg, bar);
            __builtin_amdgcn_fence(__ATOMIC_ACQUIRE, "agent");
            xb_add(&bar[XB_XGEN(b.x)], 1u);
            asm volatile("s_waitcnt vmcnt(0)" ::: "memory");
        } else {
            XB_SPIN(xb_ld(&bar[XB_XGEN(b.x)]) == gen, bar);
            __builtin_amdgcn_fence(__ATOMIC_ACQUIRE, "agent");
            asm volatile("s_waitcnt vmcnt(0)" ::: "memory");
        }
    }
    __syncthreads();
}

DI int map_col(int np) { return np < 6144 ? np : (np < 14336 ? np + 16 : (np < 14352 ? np - 14336 + 6144 : (np < 14384 ? np : -1))); }
DI void phase_convert(const Args& a, LAS float* lds, const int t, const int vb, const int nvb, const int tile_lo, const int tile_hi, const bool do_x) {
    u16* WIN = (u16*)(a.ws + WS_WIN); u16* WOUT = (u16*)(a.ws + WS_WOUT);
    constexpr int T_IN = 64 * 228, T_OUT = 64 * 64, T_L = T_IN + T_OUT;
    const int r4 = t >> 4, q4 = (t & 15) * 4, nl2 = t >> 3, kq = (t & 7) * 8;
    for (int tp = tile_lo + 2 * vb; tp < tile_hi; tp += 2 * nvb) {
        f32x4 v[2][2]; u16* dstp[2];
#pragma unroll
        for (int u = 0; u < 2; ++u) {
            const int tile = tp + u; const int l = tile / T_L; int r = tile % T_L; const float* src; u16* dst; int ldw, kt, nt; const bool isin = r < T_IN;
            if (isin) { nt = r % 228; kt = r / 228; src = a.w_in + (size_t)l * 4096 * DIN; ldw = DIN; dst = WIN + (size_t)l * NPAD * 4096; }
            else { r -= T_IN; nt = r % 64; kt = r / 64; src = a.w_out + (size_t)l * 4096 * 4096; ldw = 4096; dst = WOUT + (size_t)l * 4096 * 4096; }
            const int np = nt * 64 + q4, n = isin ? map_col(np) : np;
#pragma unroll
            for (int i = 0; i < 2; ++i) { const int kl = r4 + 32 * i; v[u][i] = n >= 0 ? __builtin_nontemporal_load((const f32x4*)(src + (size_t)(kt * 64 + kl) * ldw + n)) : (f32x4){0.f, 0.f, 0.f, 0.f}; }
            dstp[u] = dst + (size_t)(nt * 64 + nl2) * 4096 + kt * 64 + kq;
        }
#pragma unroll
        for (int u = 0; u < 2; ++u)
#pragma unroll
            for (int i = 0; i < 2; ++i) { const int kl = r4 + 32 * i;
#pragma unroll
                for (int q = 0; q < 4; ++q) lds[u * 4160 + kl * 65 + q4 + q] = v[u][i][q]; }
        lds_barrier();
#pragma unroll
        for (int u = 0; u < 2; ++u) { float f[8];
#pragma unroll
            for (int j = 0; j < 8; ++j) f[j] = lds[u * 4160 + (kq + j) * 65 + nl2];
            u32x4 o = {pk(f[0], f[1]), pk(f[2], f[3]), pk(f[4], f[5]), pk(f[6], f[7])};
            *(u32x4*)dstp[u] = o; }
        lds_barrier();
    }
    if (do_x) {
        u32x4* XB = (u32x4*)(a.ws + WS_XB); const f32x4* X4 = (const f32x4*)a.x;
        for (size_t i = (size_t)vb * 512 + t; i < (size_t)TOK * DM / 8; i += (size_t)nvb * 512) {
            const f32x4 p = __builtin_nontemporal_load(X4 + 2 * i), q = __builtin_nontemporal_load(X4 + 2 * i + 1); u32x4 o = {pk(p[0], p[1]), pk(p[2], p[3]), pk(q[0], q[1]), pk(q[2], q[3])}; XB[i] = o; }
    }
}

DI void phase_skinny(const Args& a, int l, LAS float* lds, const int t, const int bid) {
    const int w = __builtin_amdgcn_readfirstlane(t >> 6), lane = t & 63, m = lane & 31, h = lane >> 5;
    const u16* XB = (const u16*)(a.ws + WS_XB); const u16* WS = (const u16*)(a.ws + WS_WIN) + ((size_t)l * NPAD + NPJ) * 4096; float* PS = (float*)(a.ws + WS_PROJS);
    for (int rb = bid; rb < 256; rb += gridDim.x) {
        const u16* pa = XB + (size_t)(rb * 32 + m) * 4096 + w * 512 + 8 * h; const u16* pb0 = WS + (size_t)m * 4096 + w * 512 + 8 * h; const u16* pb1 = pb0 + (size_t)32 * 4096;
        f32x16 c0 = zero16(), c1 = zero16();
#pragma unroll 8
        for (int kb = 0; kb < 32; ++kb) { const bf16x8 av = *(const bf16x8*)(pa + 16 * kb), b0 = *(const bf16x8*)(pb0 + 16 * kb), b1 = *(const bf16x8*)(pb1 + 16 * kb);
            c0 = MFMA32(av, b0, c0); c1 = MFMA32(av, b1, c1); }
#pragma unroll
        for (int reg = 0; reg < 16; ++reg) { lds[w * 2048 + reg * 64 + lane] = c0[reg]; lds[w * 2048 + 1024 + reg * 64 + lane] = c1[reg]; }
        lds_barrier();
#pragma unroll
        for (int q = 0; q < 4; ++q) { const int idx = t + 512 * q; float s = 0.f;
#pragma unroll
            for (int ww = 0; ww < 8; ++ww) s += lds[ww * 2048 + idx];
            const int ln = idx & 63, reg = (idx >> 6) & 15, nt = idx >> 10;
            PS[(size_t)(rb * 32 + crow(reg, ln >> 5)) * 64 + nt * 32 + (ln & 31)] = s; }
        lds_barrier();
    }
}

constexpr int L_QS = 0, L_KS = 8448, L_VS = 16896, L_AS = 25344, L_TU = 29696, L_TW = 34048, L_MISC = 38400;

#define SCHED_BAR __builtin_amdgcn_sched_barrier(0)
DI f32x16 prod_nn(const LAS float* Xa, const LAS float* Xb, int mt, int nt, int lane) {
    const int r = lane & 31, h = lane >> 5; f32x16 acc = zero16();
    const LAS float* pa = Xa + (mt * 32 + r) * 132 + 8 * h; const LAS float* pb = Xb + (nt * 32 + r) * 132 + 8 * h;
#pragma unroll
    for (int half = 0; half < 2; ++half) {
        f32x4 va[4][2], vb[4][2];
#pragma unroll
        for (int kb = 0; kb < 4; ++kb) { const int ko = 16 * (4 * half + kb); va[kb][0] = *(const LAS f32x4*)(pa + ko); va[kb][1] = *(const LAS f32x4*)(pa + ko + 4); vb[kb][0] = *(const LAS f32x4*)(pb + ko); vb[kb][1] = *(const LAS f32x4*)(pb + ko + 4); }
        SCHED_BAR;
#pragma unroll
        for (int kb = 0; kb < 4; ++kb) {
            u32x4 ua = {pk(va[kb][0][0], va[kb][0][1]), pk(va[kb][0][2], va[kb][0][3]), pk(va[kb][1][0], va[kb][1][1]), pk(va[kb][1][2], va[kb][1][3])};
            u32x4 ub = {pk(vb[kb][0][0], vb[kb][0][1]), pk(vb[kb][0][2], vb[kb][0][3]), pk(vb[kb][1][0], vb[kb][1][1]), pk(vb[kb][1][2], vb[kb][1][3])};
            acc = MFMA32(__builtin_bit_cast(bf16x8, ua), __builtin_bit_cast(bf16x8, ub), acc); }
    }
    return acc;
}
DI void st_acc(unsigned char* dst, const f32x16& x, int lane) { *(u32x4*)(dst + lane * 16) = pack8u(x, 0); *(u32x4*)(dst + 1024 + lane * 16) = pack8u(x, 1); }
DI void qstore(unsigned char* dst, const LAS float* X, const LAS float* rs, int t0, int nth) {
    for (int lb = t0; lb < 1024; lb += nth) { const int blk = lb >> 6, ln = lb & 63, mt = blk >> 3, st = (blk >> 1) & 3, kb = blk & 1, m = ln & 31, h = ln >> 5, i = 32 * mt + m;
        const LAS float* p = X + i * 132 + 32 * st + 16 * kb + 4 * h; const f32x4 a = *(const LAS f32x4*)p, b = *(const LAS f32x4*)(p + 8); const float s = rs ? rs[i] : 1.f;
        u32x4 o = {pk(a[0] * s, a[1] * s), pk(a[2] * s, a[3] * s), pk(b[0] * s, b[1] * s), pk(b[2] * s, b[3] * s)}; *(u32x4*)(dst + blk * 1024 + ln * 16) = o; }
}
DI void ctstore(unsigned char* dst, const LAS float* X, const LAS float* rs, int t0, int nth) {
    for (int lb = t0; lb < 1024; lb += nth) { const int blk = lb >> 6, ln = lb & 63, ct = blk >> 2, jt = (blk >> 1) & 1, kb = blk & 1, n = ln & 31, h = ln >> 5; float f[8], s[8];
#pragma unroll
        for (int jj = 0; jj < 8; ++jj) { const int j = 32 * jt + 16 * kb + 8 * (jj >> 2) + 4 * h + (jj & 3); f[jj] = X[j * 132 + 32 * ct + n]; s[jj] = rs ? rs[j] : 1.f; }
        SCHED_BAR;
        u32x4 o = {pk(f[0] * s[0], f[1] * s[1]), pk(f[2] * s[2], f[3] * s[3]), pk(f[4] * s[4], f[5] * s[5]), pk(f[6] * s[6], f[7] * s[7])}; *(u32x4*)(dst + blk * 1024 + ln * 16) = o; }
}

DI void dn_raw_geom(int t, unsigned (&roff)[7], unsigned& padm) {
    padm = 0u;
#pragma unroll
    for (int q = 0; q < 7; ++q) { const int cid = t + 512 * q, srow = cid >> 4, part = cid & 15, seg = srow / 67, rr = srow - seg * 67;
        roff[q] = (unsigned)(rr * NPJ + seg * 2048 + part * 8); if (rr < 3 || cid >= 3216) padm |= (rr < 3 ? 1u : 0u) << q | (cid >= 3216 ? 0x100u : 0u) << q; }
}
DI void dn_raw_load(u32x4 (&R)[7], const u16* PROJ, int gi, const unsigned (&roff)[7], unsigned padm) {
    const int n = gi & 63, bh = gi >> 6, hh = bh & 15, b = bh >> 4;
    const u16* base = PROJ + ((size_t)(b * SEQ + n * 64) - 3) * NPJ + 6144 + hh * 128;
    const unsigned skip = (n == 0 ? (padm & 0x7fu) : 0u) | (padm >> 8);
#pragma unroll
    for (int q = 0; q < 7; ++q) { u32x4 v = {0u, 0u, 0u, 0u}; if (!((skip >> q) & 1u)) v = *(const u32x4*)(base + roff[q]); R[q] = v; }
}

DI void dn_gates(const Args& a, int l, const float* PROJS, int gi, int lane, LAS float* M, float* DDd) {
    const int n = gi & 63, bh = gi >> 6, hh = bh & 15, b = bh >> 4; const int row = b * SEQ + n * 64 + lane;
    const float bt = __builtin_amdgcn_rcpf(1.f + __expf(-PROJS[(size_t)row * 64 + 16 + hh]));
    float gcv = -__expf(a.a_log[l * 16 + hh]) * softplus(PROJS[(size_t)row * 64 + 32 + hh] + a.dt_bias[l * 16 + hh]);
#pragma unroll
    for (int o = 1; o < 64; o <<= 1) { const float up = __shfl_up(gcv, o); if (lane >= o) gcv += up; }
    const float glast = __shfl(gcv, 63);
    M[lane] = bt; M[64 + lane] = gcv; M[128 + lane] = __expf(gcv); M[192 + lane] = __expf(glast - gcv);
    DDd[lane] = __expf(glast); DDd[lane + 64] = __expf(glast);
}

DI void phase_prep(const Args& a, int l, LAS float* lds, const int tid_in, const int bid) {
    LAS float* QS = lds + L_QS; LAS float* KS = lds + L_KS; LAS float* VS = lds + L_VS; LAS float* AS = lds + L_AS; LAS float* TU = lds + L_TU; LAS float* TW = lds + L_TW;
    LAS float* GA = lds + L_MISC + 256; LAS float* SEG = lds + L_MISC + 1280;
    int gpar = 0; bool have_gates = false;
    LAS u16* RAW = (LAS u16*)AS;
    const u16* PROJ = (const u16*)(a.ws + WS_PROJ); const float* PROJS = (const float*)(a.ws + WS_PROJS);
    u32x4 RW[7]; bool have_raw = false; unsigned roff[7], padm; dn_raw_geom(tid_in, roff, padm);
    for (int g = bid; g < 3072; g += gridDim.x) {
        int t = tid_in; asm volatile("" : "+v"(t));
        const int w = __builtin_amdgcn_readfirstlane(t >> 6), lane = t & 63, r = lane & 31, h2 = lane >> 5;
        unsigned char* QPd = a.ws + WS_QP + (size_t)g * 16384; unsigned char* PPd = a.ws + WS_PP + (size_t)g * 8192; unsigned char* KTd = a.ws + WS_KT + (size_t)g * 16384;
        float* DDd = (float*)(a.ws + WS_DD + (size_t)g * 512);
        if (g < 1024) {
            const bool isret = g < 512; const int gi = isret ? g : g - 512; const int n = gi & 63, bh = gi >> 6, hh = bh & 3, b = bh >> 2; const int rowbase = b * SEQ + n * 64;
            unsigned char* UUd = a.ws + WS_UU + (size_t)g * 32768;
            const int vcol0 = (isret ? 1024 : 4096) + hh * 256;
            u32x4 vt[4];
#pragma unroll
            for (int q = 0; q < 4; ++q) { const int cid = t + 512 * q, row = cid >> 5, part = cid & 31; vt[q] = *(const u32x4*)(PROJ + (size_t)(rowbase + row) * NPJ + vcol0 + part * 8); }
            if (isret) {
                const int c = t & 63, seg = t >> 6;
                const float inv = __builtin_amdgcn_exp2f(-(float)c * (13.287712379549449f / 64.f));
                const float lg2 = __builtin_amdgcn_logf(1.f - __builtin_amdgcn_exp2f(-5.f - (float)hh));
#pragma unroll
                for (int ii = 0; ii < 8; ++ii) { const int i = seg * 8 + ii, row = rowbase + i;
                    const float ang = (float)a.pos[row] * inv; float rev = ang * 0.15915494309189535f; rev -= floorf(rev);
                    const float sn = __builtin_amdgcn_sinf(rev), cs = __builtin_amdgcn_cosf(rev);
                    const u16* pr = PROJ + (size_t)row * NPJ + hh * 128 + c;
                    const float q1 = bf2f(pr[0]), q2 = bf2f(pr[64]), k1 = bf2f(pr[512]), k2 = bf2f(pr[512 + 64]);
                    const float qa = q1 * cs - q2 * sn, qb = q1 * sn + q2 * cs, ka = k1 * cs - k2 * sn, kb = k1 * sn + k2 * cs;
                    const float e1 = __builtin_amdgcn_exp2f((float)(i + 1) * lg2) , ei = __builtin_amdgcn_exp2f(-(float)(i + 1) * lg2), ez = __builtin_amdgcn_exp2f((float)(63 - i) * lg2);
                    QS[i * 132 + c] = qa * (QSCALE * e1); QS[i * 132 + c + 64] = qb * (QSCALE * e1);
                    KS[i * 132 + c] = ka * ei; KS[i * 132 + c + 64] = kb * ei;
                    VS[i * 132 + c] = ka * ez; VS[i * 132 + c + 64] = kb * ez; }
                if (t < 128) DDd[t] = __builtin_amdgcn_exp2f(64.f * lg2);
            } else {
                if (t < 256) { const int row = t >> 2, part = t & 3; *(LAS f32x4*)(GA + row * 16 + part * 4) = *(const f32x4*)(PROJS + (size_t)(rowbase + row) * 64 + part * 4); }
                lds_barrier();
                const int c = t & 127, seg = t >> 7;
                float wv[16];
#pragma unroll
                for (int q = 0; q < 16; ++q) wv[q] = a.w_a2[(size_t)l * 16 * 512 + q * 512 + hh * 128 + c];
                const float bias = a.b_a[l * 512 + hh * 128 + c];
                float bl[16]; float run = 0.f;
#pragma unroll
                for (int ii = 0; ii < 16; ++ii) { const int i = seg * 16 + ii; float z = bias;
#pragma unroll
                    for (int q4 = 0; q4 < 4; ++q4) { const f32x4 gv = *(const LAS f32x4*)(GA + i * 16 + q4 * 4); z += gv[0] * wv[4 * q4] + gv[1] * wv[4 * q4 + 1] + gv[2] * wv[4 * q4 + 2] + gv[3] * wv[4 * q4 + 3]; }
                    const float ls = fminf(z, 0.f) - __logf(1.f + __expf(-fabsf(z)));
                    run += ls * (1.f / 16.f); bl[ii] = run; }
                SEG[seg * 128 + c] = run;
                lds_barrier();
                float off = 0.f, tot = 0.f;
#pragma unroll
                for (int s = 0; s < 4; ++s) { const float sv = SEG[s * 128 + c]; tot += sv; if (s < seg) off += sv; }
#pragma unroll
                for (int ii = 0; ii < 16; ++ii) { const int i = seg * 16 + ii, row = rowbase + i; const float bi = bl[ii] + off;
                    const u16* pr = PROJ + (size_t)row * NPJ + 3072 + hh * 128 + c;
                    const float q = bf2f(pr[0]) * QSCALE, k = bf2f(pr[512]);
                    QS[i * 132 + c] = q * __expf(bi); KS[i * 132 + c] = k * __expf(-bi); VS[i * 132 + c] = k * __expf(tot - bi); }
                if (seg == 0) DDd[c] = __expf(tot);
            }
#pragma unroll
            for (int q = 0; q < 4; ++q) { const int cid = t + 512 * q, row = cid >> 5, part = cid & 31; *(LAS u32x4*)(RAW + row * 264 + part * 8) = vt[q]; }
            lds_barrier();
#ifdef PROBE_RGFIN
            for (int prg_ = 0; prg_ < 2; ++prg_) {
#endif
            if (w < 4) {
                const int jt = w >> 1, it = w & 1; f32x16 acc = zero16();
                if (jt <= it) { acc = prod_nn(KS, QS, jt, it, lane);
#pragma unroll
                    for (int reg = 0; reg < 16; ++reg) { const int j = 32 * jt + crow(reg, h2), i = 32 * it + r; acc[reg] = (i >= j) ? acc[reg] : 0.f; } }
                st_acc(PPd + ((it * 2 + jt) * 2) * 1024, acc, lane);
            } else { qstore(QPd, QS, nullptr, t - 256, 256); ctstore(KTd, VS, nullptr, t - 256, 256); }
            for (int lb = t; lb < 2048; lb += 512) { const int blk = lb >> 6, ln = lb & 63, ct = blk >> 2, jt = (blk >> 1) & 1, kb = blk & 1, nn = ln & 31, hh2 = ln >> 5; unsigned f[8];
#pragma unroll
                for (int jj = 0; jj < 8; ++jj) { const int j = 32 * jt + 16 * kb + 8 * (jj >> 2) + 4 * hh2 + (jj & 3); f[jj] = RAW[j * 264 + 32 * ct + nn]; }
                SCHED_BAR;
                u32x4 o = {f[0] | (f[1] << 16), f[2] | (f[3] << 16), f[4] | (f[5] << 16), f[6] | (f[7] << 16)}; *(u32x4*)(UUd + blk * 1024 + ln * 16) = o; }
#ifdef PROBE_RGFIN
            }
#endif
            lds_barrier();
        } else {
            const int gi = g - 1024, n = gi & 63, bh = gi >> 6, hh = bh & 15, b = bh >> 4; const int rowbase = b * SEQ + n * 64;
            unsigned char* UUd = a.ws + WS_UU + (size_t)1024 * 32768 + (size_t)gi * 16384; unsigned char* WWd = a.ws + WS_WW + (size_t)gi * 16384;
            if (!have_raw) dn_raw_load(RW, PROJ, gi, roff, padm);
#pragma unroll
            for (int q = 0; q < 7; ++q) { if (!((padm >> (8 + q)) & 1u)) *(LAS u32x4*)(RAW + (t + 512 * q) * 8) = RW[q]; }
            LAS float* MG = lds + L_MISC + gpar * 1792; LAS float* BETA = MG; LAS float* GC = MG + 64; LAS float* EQ = MG + 128; LAS float* EK = MG + 192;
            f32x2 cwv[3][4];
#pragma unroll
            for (int mtx = 0; mtx < 3; ++mtx)
#pragma unroll
                for (int tap = 0; tap < 4; ++tap) cwv[mtx][tap] = *(const f32x2*)(a.conv_w + (size_t)l * 4 * 6144 + tap * 6144 + mtx * 2048 + hh * 128 + 2 * lane);
            if (!have_gates && w == 0) dn_gates(a, l, PROJS, gi, lane, MG, DDd);
            lds_barrier();
            {
                float sq[8], sk[8]; f32x2 yq[8], yk[8];
#pragma unroll
                for (int mtx = 0; mtx < 3; ++mtx) { const f32x2 w0 = cwv[mtx][0], w1 = cwv[mtx][1], w2 = cwv[mtx][2], w3 = cwv[mtx][3];
                    const LAS unsigned* pc = (const LAS unsigned*)(RAW + (mtx * 67 + w * 8) * 128) + lane; f32x2 xr[11];
#pragma unroll
                    for (int ii = 0; ii < 11; ++ii) { const unsigned u = pc[ii * 64]; xr[ii] = (f32x2){bflo(u), bfhi(u)}; }
#pragma unroll
                    for (int ii = 0; ii < 8; ++ii) { f32x2 y = w0 * xr[ii] + w1 * xr[ii + 1] + w2 * xr[ii + 2] + w3 * xr[ii + 3];
                        const f32x2 en = y * (-1.4426950408889634f); f32x2 d; d[0] = __builtin_amdgcn_exp2f(en[0]); d[1] = __builtin_amdgcn_exp2f(en[1]); d = d + 1.0f;
                        f32x2 rc; rc[0] = __builtin_amdgcn_rcpf(d[0]); rc[1] = __builtin_amdgcn_rcpf(d[1]); y = y * rc;
                        if (mtx == 0) { yq[ii] = y; const f32x2 p = y * y; sq[ii] = p[0] + p[1]; } else if (mtx == 1) { yk[ii] = y; const f32x2 p = y * y; sk[ii] = p[0] + p[1]; }
                        else *(LAS f32x2*)(VS + (w * 8 + ii) * 132 + 2 * lane) = y; } }
                wsum64x8(sq); wsum64x8(sk);
#pragma unroll
                for (int ii = 0; ii < 8; ++ii) { const float rq = __builtin_amdgcn_rsqf(sq[ii] + HEPS) * QSCALE, rk = __builtin_amdgcn_rsqf(sk[ii] + HEPS); const int row = w * 8 + ii;
                    *(LAS f32x2*)(QS + row * 132 + 2 * lane) = yq[ii] * rq; *(LAS f32x2*)(KS + row * 132 + 2 * lane) = yk[ii] * rk; }
            }
            lds_barrier();
            if (w < 4) {
                const int it = w >> 1, jt = w & 1; f32x16 acc = zero16();
                if (jt <= it) { acc = prod_nn(KS, KS, it, jt, lane);
#pragma unroll
                    for (int g4 = 0; g4 < 4; ++g4) { const f32x4 gci = *(const LAS f32x4*)(GC + 32 * it + 8 * g4 + 4 * h2), bei = *(const LAS f32x4*)(BETA + 32 * it + 8 * g4 + 4 * h2); const float gcj = GC[32 * jt + r];
#pragma unroll
                        for (int tt = 0; tt < 4; ++tt) { const int reg = 4 * g4 + tt, i = 32 * it + crow(reg, h2), j = 32 * jt + r; const float dl = (i > j) ? gci[tt] - gcj : 0.f;
                            acc[reg] = (i > j) ? acc[reg] * bei[tt] * __expf(dl) : 0.f; } } }
#pragma unroll
                for (int reg = 0; reg < 16; ++reg) AS[(32 * it + crow(reg, h2)) * 68 + 32 * jt + r] = acc[reg];
            } else {
                const int jt = (w - 4) >> 1, it = (w - 4) & 1; f32x16 acc = zero16();
                if (jt <= it) { acc = prod_nn(KS, QS, jt, it, lane);
#pragma unroll
                    for (int g4 = 0; g4 < 4; ++g4) { const f32x4 gcj = *(const LAS f32x4*)(GC + 32 * jt + 8 * g4 + 4 * h2); const float gci = GC[32 * it + r];
#pragma unroll
                        for (int tt = 0; tt < 4; ++tt) { const int reg = 4 * g4 + tt, j = 32 * jt + crow(reg, h2), i = 32 * it + r; const float dl = (i >= j) ? gci - gcj[tt] : 0.f;
                            acc[reg] = (i >= j) ? acc[reg] * __expf(dl) : 0.f; } } }
                st_acc(PPd + ((it * 2 + jt) * 2) * 1024, acc, lane);
            }
            lds_barrier();
            {
                const int gn = g + gridDim.x; have_raw = gn < 3072;
                if (have_raw) dn_raw_load(RW, PROJ, gn - 1024, roff, padm);
            }
#ifdef PROBE_SOLVE
            for (int prep_ = 0; prep_ < 2; ++prep_)
#endif
            if (w == 0) {
                f32x2 Tc[16];
                const int hb = lane >> 5, c = lane & 31;
                LAS float* ASo = AS + hb * (32 * 68 + 32); LAS float* TUo = TU + hb * (32 * 68 + 32) + c; LAS float* TWo = TW + hb * (32 * 68 + 32) + c;
                asm volatile("" : "+v"(ASo)); asm volatile("" : "+v"(TUo)); asm volatile("" : "+v"(TWo));
#pragma unroll
                for (int i = 0; i < 16; ++i) Tc[i] = (f32x2){0.f, 0.f};
#pragma unroll
                for (int i = 0; i < 32; ++i) { f32x2 a01 = {0.f, 0.f}, a23 = {0.f, 0.f};
#pragma unroll
                    for (int j = 0; j < i; j += 4) { const f32x4 av = *(const LAS f32x4*)(ASo + i * 68 + j); a01 += (f32x2){av[0], av[1]} * Tc[j >> 1]; a23 += (f32x2){av[2], av[3]} * Tc[(j >> 1) + 1]; }
                    const float tv = ((c == i) ? 1.f : 0.f) - ((a01[0] + a01[1]) + (a23[0] + a23[1]));
                    if (i & 1) Tc[i >> 1][1] = tv; else Tc[i >> 1][0] = tv; }
                const float bc = BETA[lane], bw = bc * EQ[lane];
#pragma unroll
                for (int i = 0; i < 32; ++i) { const float tv = (i & 1) ? Tc[i >> 1][1] : Tc[i >> 1][0];
                    ASo[i * 68 + c] = tv;
                    TUo[i * 68] = tv * bc; TWo[i * 68] = tv * bw;
                    }
                { LAS float* zu = TU + hb * 68 + 32 + c; LAS float* zw = TW + hb * 68 + 32 + c;
#pragma unroll
                    for (int i = 0; i < 16; ++i) { zu[i * 136] = 0.f; zw[i * 136] = 0.f; } }
            } else if (w == 7 && have_raw) { dn_gates(a, l, PROJS, g + gridDim.x - 1024, lane, lds + L_MISC + (gpar ^ 1) * 1792, (float*)(a.ws + WS_DD + (size_t)(g + gridDim.x) * 512)); }
            else { qstore(QPd, QS, EQ, t - 64, have_raw ? 384 : 448); ctstore(KTd, KS, EK, t - 64, have_raw ? 384 : 448); }
            have_gates = have_raw; gpar ^= 1;
            lds_barrier();
            if (w == 0) {
                f32x16 X = zero16(), T21 = zero16();
#pragma unroll
                for (int kb = 0; kb < 2; ++kb) X = MFMA32(ld_nat(AS + (32 + r) * 68 + 16 * kb + 8 * h2), ld_tr(AS + (16 * kb + 8 * h2) * 68 + r, 68), X);
#pragma unroll
                for (int s = 0; s < 2; ++s) { const LAS float* p = AS + (32 + r) * 68 + 32 + 16 * s + 4 * h2; const f32x4 a = *(const LAS f32x4*)p, b = *(const LAS f32x4*)(p + 8);
                    u32x4 ua = {pk(a[0], a[1]), pk(a[2], a[3]), pk(b[0], b[1]), pk(b[2], b[3])};
                    T21 = MFMA32(__builtin_bit_cast(bf16x8, ua), pack8(X, s), T21); }
                const float bc = BETA[r], bw = bc * EQ[r];
#pragma unroll
                for (int reg = 0; reg < 16; ++reg) { const int i = 32 + crow(reg, h2); TU[i * 68 + r] = -T21[reg] * bc; TW[i * 68 + r] = -T21[reg] * bw; }
            }
            lds_barrier();
#ifdef PROBE_D5
            for (int prep_ = 0; prep_ < 2; ++prep_)
#endif
            {
                const int it = w >> 2, ct = w & 3; f32x16 au = zero16(), aw = zero16();
                f32x4 tu[4][2], tw[4][2]; float vv[4][8], kv[4][8];
#pragma unroll
                for (int kb = 0; kb < 4; ++kb) { const LAS float* pu = TU + (32 * it + r) * 68 + 16 * kb + 8 * h2; const LAS float* pw = TW + (32 * it + r) * 68 + 16 * kb + 8 * h2;
                    tu[kb][0] = *(const LAS f32x4*)pu; tu[kb][1] = *(const LAS f32x4*)(pu + 4); tw[kb][0] = *(const LAS f32x4*)pw; tw[kb][1] = *(const LAS f32x4*)(pw + 4);
                    const LAS float* pv = VS + (16 * kb + 8 * h2) * 132 + 32 * ct + r; const LAS float* pk2 = KS + (16 * kb + 8 * h2) * 132 + 32 * ct + r;
#pragma unroll
                    for (int jj = 0; jj < 8; ++jj) { vv[kb][jj] = pv[jj * 132]; kv[kb][jj] = pk2[jj * 132]; } }
                SCHED_BAR;
#pragma unroll
                for (int kb = 0; kb < 4; ++kb) {
                    u32x4 xa = {pk(tu[kb][0][0], tu[kb][0][1]), pk(tu[kb][0][2], tu[kb][0][3]), pk(tu[kb][1][0], tu[kb][1][1]), pk(tu[kb][1][2], tu[kb][1][3])};
                    u32x4 xb = {pk(vv[kb][0], vv[kb][1]), pk(vv[kb][2], vv[kb][3]), pk(vv[kb][4], vv[kb][5]), pk(vv[kb][6], vv[kb][7])};
                    u32x4 ya = {pk(kv[kb][0], kv[kb][1]), pk(kv[kb][2], kv[kb][3]), pk(kv[kb][4], kv[kb][5]), pk(kv[kb][6], kv[kb][7])};
                    u32x4 yb = {pk(tw[kb][0][0], tw[kb][0][1]), pk(tw[kb][0][2], tw[kb][0][3]), pk(tw[kb][1][0], tw[kb][1][1]), pk(tw[kb][1][2], tw[kb][1][3])};
                    au = MFMA32(__builtin_bit_cast(bf16x8, xa), __builtin_bit_cast(bf16x8, xb), au);
                    aw = MFMA32(__builtin_bit_cast(bf16x8, ya), __builtin_bit_cast(bf16x8, yb), aw); }
#pragma unroll
                for (int reg = 0; reg < 16; ++reg) aw[reg] = -aw[reg];
                st_acc(UUd + ((ct * 2 + it) * 2) * 1024, au, lane);
                st_acc(WWd + ((it * 4 + ct) * 2) * 1024, aw, lane);
            }
            lds_barrier();
        }
    }
}
constexpr int SB_QP = 0, SB_PP = 16384, SB_KT = 24576, SB_WW = 40960, SB_UU = 57344, SB_DD = 73728, SB_SIZE = 74240;
#define GAS __attribute__((address_space(1)))
template <bool DN, bool DVEC> DI void scan_compute(LAS unsigned char* lds, u16* Ob, const int w, const int lane) {
    f32x16 S[4];
#pragma unroll
    for (int st = 0; st < 4; ++st) S[st] = zero16();
    const unsigned loff = (unsigned)((lane & 31) * DM + 8 * (lane >> 5)) * 2u;
    lds_barrier();
#define LD4(dst, o0, o1, o2, o3) do { dst[0] = *(const LAS bf16x8*)(bufp + (o0)); dst[1] = *(const LAS bf16x8*)(bufp + (o1)); dst[2] = *(const LAS bf16x8*)(bufp + (o2)); dst[3] = *(const LAS bf16x8*)(bufp + (o3)); } while (0)
#define LD_W(dst, st) LD4(dst, SB_WW + (st) * 2048, SB_WW + 8192 + (st) * 2048, SB_WW + (st) * 2048 + 1024, SB_WW + 8192 + (st) * 2048 + 1024)
#define LD_Q(dst, st) LD4(dst, SB_QP + (st) * 2048, SB_QP + 8192 + (st) * 2048, SB_QP + (st) * 2048 + 1024, SB_QP + 8192 + (st) * 2048 + 1024)
#define LD_K(dst, g) LD4(dst, SB_KT + ((g) >> 1) * 8192 + ((g) & 1) * 2048, SB_KT + ((g) >> 1) * 8192 + 4096 + ((g) & 1) * 2048, SB_KT + ((g) >> 1) * 8192 + ((g) & 1) * 2048 + 1024, SB_KT + ((g) >> 1) * 8192 + 4096 + ((g) & 1) * 2048 + 1024)
#define MF_V(A, b0, b1) do { vn[0] = MFMA32(A[0], b0, vn[0]); vn[1] = MFMA32(A[1], b0, vn[1]); vn[0] = MFMA32(A[2], b1, vn[0]); vn[1] = MFMA32(A[3], b1, vn[1]); } while (0)
#define MF_O(A, b0, b1, first) do { o[0] = MFMA32(b0, A[0], (first) ? zero16() : o[0]); o[1] = MFMA32(b0, A[1], (first) ? zero16() : o[1]); o[0] = MFMA32(b1, A[2], o[0]); o[1] = MFMA32(b1, A[3], o[1]); } while (0)
#define MF_S(A, g) do { S[2 * ((g) >> 1)] = MFMA32(A[0], vbb[(g) & 1][0], S[2 * ((g) >> 1)]); S[2 * ((g) >> 1) + 1] = MFMA32(A[1], vbb[(g) & 1][0], S[2 * ((g) >> 1) + 1]); \
        S[2 * ((g) >> 1)] = MFMA32(A[2], vbb[(g) & 1][1], S[2 * ((g) >> 1)]); S[2 * ((g) >> 1) + 1] = MFMA32(A[3], vbb[(g) & 1][1], S[2 * ((g) >> 1) + 1]); } while (0)
#define SCHED __builtin_amdgcn_sched_barrier(0)
    for (int n = 0; n < 64; ++n) {
        const LAS unsigned char* bufp = lds + (n & 1) * SB_SIZE + lane * 16;
        bf16x8 F[8];
        const LAS u32x4* up = (const LAS u32x4*)(bufp + SB_UU + w * 4096);
        f32x16 vn[2]; bf16x8 vbb[2][2];
#pragma unroll
        for (int jt = 0; jt < 2; ++jt)
#pragma unroll
            for (int kb = 0; kb < 2; ++kb) { const u32x4 v = up[(jt * 2 + kb) * 64];
                if (DN) {
#pragma unroll
                    for (int q = 0; q < 4; ++q) { vn[jt][8 * kb + 2 * q] = bflo(v[q]); vn[jt][8 * kb + 2 * q + 1] = bfhi(v[q]); } }
                else vbb[jt][kb] = __builtin_bit_cast(bf16x8, v); }
        f32x16 o[2]; bf16x8 s0, s1;
#define PACK_V() do { _Pragma("unroll") for (int jt = 0; jt < 2; ++jt) { vbb[jt][0] = pack8(vn[jt], 0); vbb[jt][1] = pack8(vn[jt], 1); } } while (0)
#define SCALE_S() do { if (DVEC) { const LAS float* dp = (const LAS float*)(lds + (n & 1) * SB_SIZE + SB_DD) + 4 * (lane >> 5); \
            _Pragma("unroll") for (int st = 0; st < 4; ++st) _Pragma("unroll") for (int gq = 0; gq < 4; ++gq) { const f32x4 dv = *(const LAS f32x4*)(dp + 32 * st + 8 * gq); \
                _Pragma("unroll") for (int q = 0; q < 4; ++q) S[st][4 * gq + q] *= dv[q]; } } \
          else { const float dsc = *(const LAS float*)(lds + (n & 1) * SB_SIZE + SB_DD); _Pragma("unroll") for (int st = 0; st < 4; ++st) S[st] = S[st] * dsc; } } while (0)
#define STORE_O() do { GAS char* Op = (GAS char*)(Ob + (size_t)(n * 64) * DM) + loff; \
            _Pragma("unroll") for (int it = 0; it < 2; ++it) _Pragma("unroll") for (int p = 0; p < 2; ++p) { const int g = 2 * p; \
                unsigned ax = pk(o[it][4 * g], o[it][4 * g + 1]), ay = pk(o[it][4 * g + 2], o[it][4 * g + 3]), bx = pk(o[it][4 * g + 4], o[it][4 * g + 5]), by = pk(o[it][4 * g + 6], o[it][4 * g + 7]); \
                { auto rx = __builtin_amdgcn_permlane32_swap(ax, bx, false, false); ax = rx[0]; bx = rx[1]; } \
                { auto ry = __builtin_amdgcn_permlane32_swap(ay, by, false, false); ay = ry[0]; by = ry[1]; } \
                u32x4 ov = {ax, ay, bx, by}; *(GAS u32x4*)(Op + (size_t)(32 * it) * DM * 2 + 32 * p) = ov; } } while (0)
        if (DN) {
            F[0] = *(const LAS bf16x8*)(bufp + SB_WW + 0);
            F[1] = *(const LAS bf16x8*)(bufp + SB_WW + 8192);
            F[2] = *(const LAS bf16x8*)(bufp + SB_WW + 1024);
            F[3] = *(const LAS bf16x8*)(bufp + SB_WW + 9216);
            F[4] = *(const LAS bf16x8*)(bufp + SB_QP + 0);
            F[5] = *(const LAS bf16x8*)(bufp + SB_QP + 8192);
            F[6] = *(const LAS bf16x8*)(bufp + SB_QP + 1024);
            SCHED;
            F[7] = *(const LAS bf16x8*)(bufp + SB_QP + 9216); s0 = pack8(S[0], 0); s1 = pack8(S[0], 1); vn[0] = MFMA32(F[0], s0, vn[0]); SCHED;
            F[0] = *(const LAS bf16x8*)(bufp + SB_WW + 2048);  vn[1] = MFMA32(F[1], s0, vn[1]); SCHED;
            F[1] = *(const LAS bf16x8*)(bufp + SB_WW + 10240);  vn[0] = MFMA32(F[2], s1, vn[0]); SCHED;
            F[2] = *(const LAS bf16x8*)(bufp + SB_WW + 3072);  vn[1] = MFMA32(F[3], s1, vn[1]); SCHED;
            F[3] = *(const LAS bf16x8*)(bufp + SB_WW + 11264);  o[0] = MFMA32(s0, F[4], zero16()); SCHED;
            F[4] = *(const LAS bf16x8*)(bufp + SB_QP + 2048);  o[1] = MFMA32(s0, F[5], zero16()); SCHED;
            F[5] = *(const LAS bf16x8*)(bufp + SB_QP + 10240);  o[0] = MFMA32(s1, F[6], o[0]); SCHED;
            F[6] = *(const LAS bf16x8*)(bufp + SB_QP + 3072);  o[1] = MFMA32(s1, F[7], o[1]); SCHED;
            F[7] = *(const LAS bf16x8*)(bufp + SB_QP + 11264); s0 = pack8(S[1], 0); s1 = pack8(S[1], 1); vn[0] = MFMA32(F[0], s0, vn[0]); SCHED;
            F[0] = *(const LAS bf16x8*)(bufp + SB_WW + 4096);  vn[1] = MFMA32(F[1], s0, vn[1]); SCHED;
            F[1] = *(const LAS bf16x8*)(bufp + SB_WW + 12288);  vn[0] = MFMA32(F[2], s1, vn[0]); SCHED;
            F[2] = *(const LAS bf16x8*)(bufp + SB_WW + 5120);  vn[1] = MFMA32(F[3], s1, vn[1]); SCHED;
            F[3] = *(const LAS bf16x8*)(bufp + SB_WW + 13312);  o[0] = MFMA32(s0, F[4], o[0]); SCHED;
            F[4] = *(const LAS bf16x8*)(bufp + SB_QP + 4096);  o[1] = MFMA32(s0, F[5], o[1]); SCHED;
            F[5] = *(const LAS bf16x8*)(bufp + SB_QP + 12288);  o[0] = MFMA32(s1, F[6], o[0]); SCHED;
            F[6] = *(const LAS bf16x8*)(bufp + SB_QP + 5120);  o[1] = MFMA32(s1, F[7], o[1]); SCHED;
            F[7] = *(const LAS bf16x8*)(bufp + SB_QP + 13312); s0 = pack8(S[2], 0); s1 = pack8(S[2], 1); vn[0] = MFMA32(F[0], s0, vn[0]); SCHED;
            F[0] = *(const LAS bf16x8*)(bufp + SB_WW + 6144);  vn[1] = MFMA32(F[1], s0, vn[1]); SCHED;
            F[1] = *(const LAS bf16x8*)(bufp + SB_WW + 14336);  vn[0] = MFMA32(F[2], s1, vn[0]); SCHED;
            F[2] = *(const LAS bf16x8*)(bufp + SB_WW + 7168);  vn[1] = MFMA32(F[3], s1, vn[1]); SCHED;
            F[3] = *(const LAS bf16x8*)(bufp + SB_WW + 15360);  o[0] = MFMA32(s0, F[4], o[0]); SCHED;
            F[4] = *(const LAS bf16x8*)(bufp + SB_QP + 6144);  o[1] = MFMA32(s0, F[5], o[1]); SCHED;
            F[5] = *(const LAS bf16x8*)(bufp + SB_QP + 14336);  o[0] = MFMA32(s1, F[6], o[0]); SCHED;
            F[6] = *(const LAS bf16x8*)(bufp + SB_QP + 7168);  o[1] = MFMA32(s1, F[7], o[1]); SCHED;
            F[7] = *(const LAS bf16x8*)(bufp + SB_QP + 15360); s0 = pack8(S[3], 0); s1 = pack8(S[3], 1); vn[0] = MFMA32(F[0], s0, vn[0]); SCHED;
            F[0] = *(const LAS bf16x8*)(bufp + SB_PP + 4096);  vn[1] = MFMA32(F[1], s0, vn[1]); SCHED;
            F[1] = *(const LAS bf16x8*)(bufp + SB_PP + 0);  vn[0] = MFMA32(F[2], s1, vn[0]); SCHED;
            F[2] = *(const LAS bf16x8*)(bufp + SB_PP + 5120);  vn[1] = MFMA32(F[3], s1, vn[1]); SCHED;
            F[3] = *(const LAS bf16x8*)(bufp + SB_PP + 1024);  o[0] = MFMA32(s0, F[4], o[0]); SCHED;
            F[4] = *(const LAS bf16x8*)(bufp + SB_PP + 6144);  o[1] = MFMA32(s0, F[5], o[1]); SCHED;
            F[5] = *(const LAS bf16x8*)(bufp + SB_PP + 7168);  o[0] = MFMA32(s1, F[6], o[0]); SCHED;
            F[6] = *(const LAS bf16x8*)(bufp + SB_KT + 0);  o[1] = MFMA32(s1, F[7], o[1]); SCHED;
            F[7] = *(const LAS bf16x8*)(bufp + SB_KT + 4096); PACK_V(); o[1] = MFMA32(vbb[0][0], F[0], o[1]); SCHED;
            F[0] = *(const LAS bf16x8*)(bufp + SB_KT + 1024);  o[0] = MFMA32(vbb[0][0], F[1], o[0]); SCHED;
            F[1] = *(const LAS bf16x8*)(bufp + SB_KT + 5120);  o[1] = MFMA32(vbb[0][1], F[2], o[1]); SCHED;
            F[2] = *(const LAS bf16x8*)(bufp + SB_KT + 2048);  o[0] = MFMA32(vbb[0][1], F[3], o[0]); SCHED;
            F[3] = *(const LAS bf16x8*)(bufp + SB_KT + 6144);  o[1] = MFMA32(vbb[1][0], F[4], o[1]); SCHED;
            F[4] = *(const LAS bf16x8*)(bufp + SB_KT + 3072);  o[1] = MFMA32(vbb[1][1], F[5], o[1]); SCHED;
            F[5] = *(const LAS bf16x8*)(bufp + SB_KT + 7168); SCALE_S(); S[0] = MFMA32(F[6], vbb[0][0], S[0]); SCHED;
            F[6] = *(const LAS bf16x8*)(bufp + SB_KT + 8192);  S[1] = MFMA32(F[7], vbb[0][0], S[1]); SCHED;
            F[7] = *(const LAS bf16x8*)(bufp + SB_KT + 12288);  S[0] = MFMA32(F[0], vbb[0][1], S[0]); SCHED;
            F[0] = *(const LAS bf16x8*)(bufp + SB_KT + 9216);  S[1] = MFMA32(F[1], vbb[0][1], S[1]); SCHED;
            F[1] = *(const LAS bf16x8*)(bufp + SB_KT + 13312);  S[0] = MFMA32(F[2], vbb[1][0], S[0]); SCHED;
            F[2] = *(const LAS bf16x8*)(bufp + SB_KT + 10240);  S[1] = MFMA32(F[3], vbb[1][0], S[1]); SCHED;
            F[3] = *(const LAS bf16x8*)(bufp + SB_KT + 14336);  S[0] = MFMA32(F[4], vbb[1][1], S[0]); SCHED;
            F[4] = *(const LAS bf16x8*)(bufp + SB_KT + 11264);  S[1] = MFMA32(F[5], vbb[1][1], S[1]); SCHED;
            STORE_O();
            F[5] = *(const LAS bf16x8*)(bufp + SB_KT + 15360);  S[2] = MFMA32(F[6], vbb[0][0], S[2]); SCHED;
             S[3] = MFMA32(F[7], vbb[0][0], S[3]); SCHED;
             S[2] = MFMA32(F[0], vbb[0][1], S[2]); SCHED;
             S[3] = MFMA32(F[1], vbb[0][1], S[3]); SCHED;
             S[2] = MFMA32(F[2], vbb[1][0], S[2]); SCHED;
             S[3] = MFMA32(F[3], vbb[1][0], S[3]); SCHED;
             S[2] = MFMA32(F[4], vbb[1][1], S[2]); SCHED;
             S[3] = MFMA32(F[5], vbb[1][1], S[3]); SCHED;
        } else {
            F[0] = *(const LAS bf16x8*)(bufp + SB_QP + 0);
            F[1] = *(const LAS bf16x8*)(bufp + SB_QP + 8192);
            F[2] = *(const LAS bf16x8*)(bufp + SB_QP + 1024);
            F[3] = *(const LAS bf16x8*)(bufp + SB_QP + 9216);
            F[4] = *(const LAS bf16x8*)(bufp + SB_QP + 2048);
            F[5] = *(const LAS bf16x8*)(bufp + SB_QP + 10240);
            F[6] = *(const LAS bf16x8*)(bufp + SB_QP + 3072);
            SCHED;
            F[7] = *(const LAS bf16x8*)(bufp + SB_QP + 11264); s0 = pack8(S[0], 0); s1 = pack8(S[0], 1); o[0] = MFMA32(s0, F[0], zero16()); SCHED;
            F[0] = *(const LAS bf16x8*)(bufp + SB_QP + 4096);  o[1] = MFMA32(s0, F[1], zero16()); SCHED;
            F[1] = *(const LAS bf16x8*)(bufp + SB_QP + 12288);  o[0] = MFMA32(s1, F[2], o[0]); SCHED;
            F[2] = *(const LAS bf16x8*)(bufp + SB_QP + 5120);  o[1] = MFMA32(s1, F[3], o[1]); SCHED;
            F[3] = *(const LAS bf16x8*)(bufp + SB_QP + 13312); s0 = pack8(S[1], 0); s1 = pack8(S[1], 1); o[0] = MFMA32(s0, F[4], o[0]); SCHED;
            F[4] = *(const LAS bf16x8*)(bufp + SB_QP + 6144);  o[1] = MFMA32(s0, F[5], o[1]); SCHED;
            F[5] = *(const LAS bf16x8*)(bufp + SB_QP + 14336);  o[0] = MFMA32(s1, F[6], o[0]); SCHED;
            F[6] = *(const LAS bf16x8*)(bufp + SB_QP + 7168);  o[1] = MFMA32(s1, F[7], o[1]); SCHED;
            F[7] = *(const LAS bf16x8*)(bufp + SB_QP + 15360); s0 = pack8(S[2], 0); s1 = pack8(S[2], 1); o[0] = MFMA32(s0, F[0], o[0]); SCHED;
            F[0] = *(const LAS bf16x8*)(bufp + SB_PP + 4096);  o[1] = MFMA32(s0, F[1], o[1]); SCHED;
            F[1] = *(const LAS bf16x8*)(bufp + SB_PP + 0);  o[0] = MFMA32(s1, F[2], o[0]); SCHED;
            F[2] = *(const LAS bf16x8*)(bufp + SB_PP + 5120);  o[1] = MFMA32(s1, F[3], o[1]); SCHED;
            F[3] = *(const LAS bf16x8*)(bufp + SB_PP + 1024); s0 = pack8(S[3], 0); s1 = pack8(S[3], 1); o[0] = MFMA32(s0, F[4], o[0]); SCHED;
            F[4] = *(const LAS bf16x8*)(bufp + SB_PP + 6144);  o[1] = MFMA32(s0, F[5], o[1]); SCHED;
            F[5] = *(const LAS bf16x8*)(bufp + SB_PP + 7168);  o[0] = MFMA32(s1, F[6], o[0]); SCHED;
            F[6] = *(const LAS bf16x8*)(bufp + SB_KT + 0);  o[1] = MFMA32(s1, F[7], o[1]); SCHED;
            F[7] = *(const LAS bf16x8*)(bufp + SB_KT + 4096);  o[1] = MFMA32(vbb[0][0], F[0], o[1]); SCHED;
            F[0] = *(const LAS bf16x8*)(bufp + SB_KT + 1024);  o[0] = MFMA32(vbb[0][0], F[1], o[0]); SCHED;
            F[1] = *(const LAS bf16x8*)(bufp + SB_KT + 5120);  o[1] = MFMA32(vbb[0][1], F[2], o[1]); SCHED;
            F[2] = *(const LAS bf16x8*)(bufp + SB_KT + 2048);  o[0] = MFMA32(vbb[0][1], F[3], o[0]); SCHED;
            F[3] = *(const LAS bf16x8*)(bufp + SB_KT + 6144);  o[1] = MFMA32(vbb[1][0], F[4], o[1]); SCHED;
            F[4] = *(const LAS bf16x8*)(bufp + SB_KT + 3072);  o[1] = MFMA32(vbb[1][1], F[5], o[1]); SCHED;
            F[5] = *(const LAS bf16x8*)(bufp + SB_KT + 7168); SCALE_S(); S[0] = MFMA32(F[6], vbb[0][0], S[0]); SCHED;
            F[6] = *(const LAS bf16x8*)(bufp + SB_KT + 8192);  S[1] = MFMA32(F[7], vbb[0][0], S[1]); SCHED;
            F[7] = *(const LAS bf16x8*)(bufp + SB_KT + 12288);  S[0] = MFMA32(F[0], vbb[0][1], S[0]); SCHED;
            F[0] = *(const LAS bf16x8*)(bufp + SB_KT + 9216);  S[1] = MFMA32(F[1], vbb[0][1], S[1]); SCHED;
            F[1] = *(const LAS bf16x8*)(bufp + SB_KT + 13312);  S[0] = MFMA32(F[2], vbb[1][0], S[0]); SCHED;
            F[2] = *(const LAS bf16x8*)(bufp + SB_KT + 10240);  S[1] = MFMA32(F[3], vbb[1][0], S[1]); SCHED;
            F[3] = *(const LAS bf16x8*)(bufp + SB_KT + 14336);  S[0] = MFMA32(F[4], vbb[1][1], S[0]); SCHED;
            F[4] = *(const LAS bf16x8*)(bufp + SB_KT + 11264);  S[1] = MFMA32(F[5], vbb[1][1], S[1]); SCHED;
            STORE_O();
            F[5] = *(const LAS bf16x8*)(bufp + SB_KT + 15360);  S[2] = MFMA32(F[6], vbb[0][0], S[2]); SCHED;
             S[3] = MFMA32(F[7], vbb[0][0], S[3]); SCHED;
             S[2] = MFMA32(F[0], vbb[0][1], S[2]); SCHED;
             S[3] = MFMA32(F[1], vbb[0][1], S[3]); SCHED;
             S[2] = MFMA32(F[2], vbb[1][0], S[2]); SCHED;
             S[3] = MFMA32(F[3], vbb[1][0], S[3]); SCHED;
             S[2] = MFMA32(F[4], vbb[1][1], S[2]); SCHED;
             S[3] = MFMA32(F[5], vbb[1][1], S[3]); SCHED;
        }
        lds_barrier();
    }
#undef PACK_V
#undef SCALE_S
#undef STORE_O
#undef LD4
#undef LD_W
#undef LD_Q
#undef LD_K
#undef MF_V
#undef MF_O
#undef MF_S
#undef SCHED
}
template <int NT> DI void phase_scan(const Args& a, LAS unsigned char* lds, const int t, const int bid) {
    const int w = __builtin_amdgcn_readfirstlane(t >> 6), lane = t & 63, r = lane & 31, h2 = lane >> 5;
    u16* O = (u16*)(a.ws + WS_O);
    constexpr int PER = 4 / NT, PER2 = 8 / NT, NVB = 32 * PER + 16 * PER2;
    for (int vb = bid; vb < NVB; vb += gridDim.x) {
        int type, bh, cb, g0, colbase, b; size_t ustride; const unsigned char* UUp; const unsigned char* WWp = nullptr;
        if (vb < 32 * PER) { const int y = vb >> 3, x = vb & 7, sub = y % PER; type = 2; bh = (y / PER) * 8 + x; cb = sub * NT; g0 = 1024 + bh * 64; b = bh >> 4; colbase = 2048 + (bh & 15) * 128; ustride = 16384; UUp = a.ws + WS_UU + (size_t)1024 * 32768 + (size_t)(bh * 64) * 16384 + (size_t)cb * 4096; WWp = a.ws + WS_WW + (size_t)(bh * 64) * 16384; }
        else { const int v2 = vb - 32 * PER, y = v2 >> 3, x = v2 & 7, sub = y % PER2, unit = (y / PER2) * 8 + x; type = unit >> 3; bh = unit & 7; cb = sub * NT; g0 = type * 512 + bh * 64; b = bh >> 2; colbase = type * 1024 + (bh & 3) * 256; ustride = 32768; UUp = a.ws + WS_UU + (size_t)g0 * 32768 + (size_t)cb * 4096; }
        const unsigned char* QPp = a.ws + WS_QP + (size_t)g0 * 16384; const unsigned char* PPp = a.ws + WS_PP + (size_t)g0 * 8192; const unsigned char* KTp = a.ws + WS_KT + (size_t)g0 * 16384;
        const unsigned char* DDp = a.ws + WS_DD + (size_t)g0 * 512;
        if (w >= 4) {
            const int tl = t - 256; u32x4 RA[19], RB[19];
#define SCAN_GLOAD(R, n_) do { const int n__ = (n_); \
                { const u32x4* q_ = (const u32x4*)(QPp + (size_t)n__ * 16384) + tl; R[0] = q_[0]; R[1] = q_[256]; R[2] = q_[512]; R[3] = q_[768]; } \
                { const u32x4* q_ = (const u32x4*)(PPp + (size_t)n__ * 8192) + tl; R[4] = q_[0]; R[5] = q_[256]; } \
                { const u32x4* q_ = (const u32x4*)(KTp + (size_t)n__ * 16384) + tl; R[6] = q_[0]; R[7] = q_[256]; R[8] = q_[512]; R[9] = q_[768]; } \
                { const u32x4* q_ = (const u32x4*)(UUp + (size_t)n__ * ustride) + tl; R[10] = q_[0]; if (NT >= 2) R[11] = q_[256]; if (NT == 4) { R[12] = q_[512]; R[13] = q_[768]; } } \
                if (type == 2) { const u32x4* q_ = (const u32x4*)(WWp + (size_t)n__ * 16384) + tl; R[14] = q_[0]; R[15] = q_[256]; R[16] = q_[512]; R[17] = q_[768]; } \
                if (tl < 32) R[18] = ((const u32x4*)(DDp + (size_t)n__ * 512))[tl]; } while (0)
#define SCAN_LSTORE(R, buf_) do { LAS u32x4* d_ = (LAS u32x4*)(lds + (buf_) * SB_SIZE) + tl; \
                d_[SB_QP / 16] = R[0]; d_[SB_QP / 16 + 256] = R[1]; d_[SB_QP / 16 + 512] = R[2]; d_[SB_QP / 16 + 768] = R[3]; \
                d_[SB_PP / 16] = R[4]; d_[SB_PP / 16 + 256] = R[5]; \
                d_[SB_KT / 16] = R[6]; d_[SB_KT / 16 + 256] = R[7]; d_[SB_KT / 16 + 512] = R[8]; d_[SB_KT / 16 + 768] = R[9]; \
                d_[SB_UU / 16] = R[10]; if (NT >= 2) d_[SB_UU / 16 + 256] = R[11]; if (NT == 4) { d_[SB_UU / 16 + 512] = R[12]; d_[SB_UU / 16 + 768] = R[13]; } \
                if (type == 2) { d_[SB_WW / 16] = R[14]; d_[SB_WW / 16 + 256] = R[15]; d_[SB_WW / 16 + 512] = R[16]; d_[SB_WW / 16 + 768] = R[17]; } \
                if (tl < 32) d_[SB_DD / 16] = R[18]; } while (0)
            SCAN_GLOAD(RA, 0); SCAN_LSTORE(RA, 0); SCAN_GLOAD(RA, 1); SCAN_GLOAD(RB, 2);
            lds_barrier();
            for (int n = 0; n < 64; n += 2) {
                SCAN_LSTORE(RA, 1); if (n + 3 < 64) SCAN_GLOAD(RA, n + 3);
                lds_barrier();
                if (n + 2 < 64) { SCAN_LSTORE(RB, 0); if (n + 4 < 64) SCAN_GLOAD(RB, n + 4); }
                lds_barrier();
            }
#undef SCAN_GLOAD
#undef SCAN_LSTORE
        } else if (w >= NT) {
            lds_barrier();
            for (int n = 0; n < 64; ++n) lds_barrier();
        } else {
            u16* Ob = O + (size_t)(b * SEQ) * DM + colbase + 32 * (cb + w);
            if (type == 2) scan_compute<true, false>(lds, Ob, w, lane); else if (type == 1) scan_compute<false, true>(lds, Ob, w, lane); else scan_compute<false, false>(lds, Ob, w, lane);
        }
    }
}

DI void phase_norm(const Args& a, int l, const int t, const int bid) {
    const int w = t >> 6, lane = t & 63;
    const u16* O = (const u16*)(a.ws + WS_O); const u16* PROJ = (const u16*)(a.ws + WS_PROJ); u16* MIX = (u16*)(a.ws + WS_MIX);
    for (int row = bid * 8 + w; row < TOK; row += gridDim.x * 8) {
        const u16* orow = O + (size_t)row * DM; const u16* prow = PROJ + (size_t)row * NPJ;
#pragma unroll
        for (int seg = 0; seg < 8; ++seg) {
            const int c = seg * 512 + lane * 8; const u32x4 ov = __builtin_nontemporal_load((const u32x4*)(orow + c));
            float v[8];
#pragma unroll
            for (int q = 0; q < 4; ++q) { v[2 * q] = bflo(ov[q]); v[2 * q + 1] = bfhi(ov[q]); }
            const float* gp; int gcol; float sc;
            if (seg < 2) { float s = 0.f, s2 = 0.f;
#pragma unroll
                for (int q = 0; q < 8; ++q) { s += v[q]; s2 += v[q] * v[q]; }
                const float mu = wsum32(s) * (1.f / 256.f); const float var = fmaxf(wsum32(s2) * (1.f / 256.f) - mu * mu, 0.f);
#pragma unroll
                for (int q = 0; q < 8; ++q) v[q] -= mu;
                sc = __builtin_amdgcn_rsqf(var + HEPS); gp = a.ret_g + l * 1024 + c; gcol = 2048 + c; }
            else { float s2 = 0.f;
#pragma unroll
                for (int q = 0; q < 8; ++q) s2 += v[q] * v[q];
                if (seg < 4) { sc = __builtin_amdgcn_rsqf(wsum32(s2) * (1.f / 256.f) + HEPS); gp = a.gla_g + l * 1024 + (c - 1024); gcol = 5120 + (c - 1024); }
                else { sc = __builtin_amdgcn_rsqf(row_sum16(s2) * (1.f / 128.f) + HEPS); gp = a.dn_g + l * 2048 + (c - 2048); gcol = 12288 + (c - 2048); } }
            const f32x4 g0 = *(const f32x4*)gp, g1 = *(const f32x4*)(gp + 4); const u32x4 gt = __builtin_nontemporal_load((const u32x4*)(prow + gcol));
            float y[8];
#pragma unroll
            for (int q = 0; q < 4; ++q) { y[2 * q] = v[2 * q] * sc * (q < 2 ? g0[2 * q] : g1[2 * q - 4]) * silu(bflo(gt[q])); y[2 * q + 1] = v[2 * q + 1] * sc * (q < 2 ? g0[2 * q + 1] : g1[2 * q - 3]) * silu(bfhi(gt[q])); }
            u32x4 o = {pk(y[0], y[1]), pk(y[2], y[3]), pk(y[4], y[5]), pk(y[6], y[7])};
            *(u32x4*)(MIX + (size_t)row * DM + c) = o;
        }
    }
}

DI void phase_ln(const Args& a, int l, const int t, const int bid) {
    const int w = t >> 6, lane = t & 63;
    const u16* Z = (const u16*)(a.ws + WS_Z); u16* XH = (u16*)(a.ws + WS_XF); u16* XB = (u16*)(a.ws + WS_XB);
    const float* G = a.ln_g + l * DM; const float* Bv = a.ln_b + l * DM;
    for (int row = bid * 8 + w; row < TOK; row += gridDim.x * 8) {
        float v[8][8]; float s = 0.f;
#pragma unroll
        for (int q = 0; q < 8; ++q) { const u32x4 zv = __builtin_nontemporal_load((const u32x4*)(Z + (size_t)row * DM + q * 512 + lane * 8));
#pragma unroll
            for (int j = 0; j < 4; ++j) { v[q][2 * j] = hlo(zv[j]); v[q][2 * j + 1] = hhi(zv[j]); s += v[q][2 * j] + v[q][2 * j + 1]; } }
        const float mu = wsum64(s) * (1.f / 4096.f); float s2 = 0.f;
#pragma unroll
        for (int q = 0; q < 8; ++q)
#pragma unroll
            for (int j = 0; j < 8; ++j) { v[q][j] -= mu; s2 += v[q][j] * v[q][j]; }
        const float rstd = __builtin_amdgcn_rsqf(wsum64(s2) * (1.f / 4096.f) + LNEPS);
#pragma unroll
        for (int q = 0; q < 8; ++q) { const int c = q * 512 + lane * 8; const f32x4 g0 = *(const f32x4*)(G + c), g1 = *(const f32x4*)(G + c + 4), b0 = *(const f32x4*)(Bv + c), b1 = *(const f32x4*)(Bv + c + 4);
            f32x4 y0, y1;
#pragma unroll
            for (int j = 0; j < 4; ++j) { y0[j] = v[q][j] * rstd * g0[j] + b0[j]; y1[j] = v[q][4 + j] * rstd * g1[j] + b1[j]; }
            if (l == 1) { *(f32x4*)(a.out + (size_t)row * DM + c) = y0; *(f32x4*)(a.out + (size_t)row * DM + c + 4) = y1; }
            else { u32x4 oh = {pkh(y0[0], y0[1]), pkh(y0[2], y0[3]), pkh(y1[0], y1[1]), pkh(y1[2], y1[3])}; *(u32x4*)(XH + (size_t)row * DM + c) = oh;
                   u32x4 ob = {pk(y0[0], y0[1]), pk(y0[2], y0[3]), pk(y1[0], y1[1]), pk(y1[2], y1[3])}; *(u32x4*)(XB + (size_t)row * DM + c) = ob; } }
    }
}

__global__ void __launch_bounds__(512, 2) hybrid_fwd(Args a) {
    extern __shared__ __attribute__((aligned(16))) unsigned char smem[];
    cg::grid_group grid = cg::this_grid();
    LAS float* ldsf = (LAS float*)smem;
    volatile LAS unsigned* xst = (volatile LAS unsigned*)(smem + LDS_BYTES - 16);
    if (threadIdx.x == 0) { xst[0] = 0u; xst[1] = 0u; }
    __syncthreads();
    const XcdBarrier xbar = xcd_barrier_post((unsigned*)(a.ws + WS_BAR), xst);
    for (int ph = a.ph_lo; ph < a.ph_hi; ++ph) {
        if (ph > a.ph_lo) { if (a.ph_hi > NPHASE) grid.sync();
            xcd_barrier(xbar); }
        int tid = threadIdx.x, bid = blockIdx.x; asm volatile("" : "+v"(tid)); asm volatile("" : "+s"(bid));
        if (ph == 0) {
#ifndef NO_CONV
 for (int rep = 0; rep < REP_CONV; ++rep) { phase_convert(a, ldsf, tid, bid, gridDim.x, 0, gridDim.x >= 256 ? 18688 : 2 * 18688, true); __syncthreads(); }
#endif
 continue; }
        const int l = (ph - 1) / 6, sub = (ph - 1) % 6;
        if (sub == 0) {
#ifndef NO_G1
            pg8::Gemm g; g.A = (const pg8::bf16_t*)(a.ws + WS_XB); g.Bt = (const pg8::bf16_t*)(a.ws + WS_WIN) + (size_t)l * NPAD * 4096; g.M = TOK; g.N = NPJ; g.K = 4096;
            pg8::StaticOrder so; so.init(TOK, NPJ, gridDim.x, bid);
            EpiProj e; e.O = (u16*)(a.ws + WS_PROJ);
            for (int rep = 0; rep < REP_G1; ++rep) { pg8::gemm_phase<EpiProj, pg8::StaticOrder, false>((LAS unsigned char*)smem, g, so, e, nullptr, tid);
            __syncthreads(); }
            phase_skinny(a, l, ldsf, tid, bid);
#endif
        } else if (sub == 1) {
#ifndef NO_PREP
 for (int rep = 0; rep < REP_PREP; ++rep) { phase_prep(a, l, ldsf, tid, bid); __syncthreads(); }
#endif
 }
        else if (sub == 2) {
#ifndef NO_SCAN
 for (int rep = 0; rep < REP_SCAN; ++rep) { if (gridDim.x < 256) phase_scan<4>(a, (LAS unsigned char*)smem, tid, bid); else if (l == 0) phase_scan<2>(a, (LAS unsigned char*)smem, tid, bid); else phase_scan<1>(a, (LAS unsigned char*)smem, tid, bid); __syncthreads(); }
            if (gridDim.x >= 256 && l == 0 && bid >= 128) phase_convert(a, ldsf, tid, bid - 128, gridDim.x - 128, 18688, 2 * 18688, false);
#endif
 }
        else if (sub == 3) {
#ifndef NO_NORM
 for (int rep = 0; rep < REP_NORM; ++rep) phase_norm(a, l, tid, bid);
#endif
 }
        else if (sub == 4) {
#ifndef NO_G2
            pg8::Gemm g; g.A = (const pg8::bf16_t*)(a.ws + WS_MIX); g.Bt = (const pg8::bf16_t*)(a.ws + WS_WOUT) + (size_t)l * 4096 * 4096; g.M = TOK; g.N = DM; g.K = 4096;
            pg8::StaticOrder so; so.init(TOK, DM, gridDim.x, bid);
            EpiZ e; e.Z = (u16*)(a.ws + WS_Z); e.X = (l == 0) ? a.x : nullptr; e.XH = (const u16*)(a.ws + WS_XF);
            for (int rep = 0; rep < REP_G2; ++rep) { pg8::gemm_phase<EpiZ, pg8::StaticOrder, false>((LAS unsigned char*)smem, g, so, e, nullptr, tid);
            __syncthreads(); }
#endif
        } else {
#ifndef NO_LN
 for (int rep = 0; rep < REP_LN; ++rep) phase_ln(a, l, tid, bid);
#endif
 }
    }
}

extern "C" void kernel_launch(void* const* d_in, const int* in_sizes, int n_in, void* d_out, int out_size, void* d_ws, size_t ws_size, hipStream_t stream) {
    static int grid = 0;
    if (grid == 0) {
        if (n_in != 14 || ws_size < WS_END) { fprintf(stderr, "kernel_launch: unexpected inputs (n_in %d, ws %zu < %zu)\n", n_in, ws_size, (size_t)WS_END); grid = -1; return; }
        int dev = 0, cus = 0, per_cu = 0;
        hipGetDevice(&dev); hipDeviceGetAttribute(&cus, hipDeviceAttributeMultiprocessorCount, dev);
        if (hipFuncSetAttribute((const void*)hybrid_fwd, hipFuncAttributeMaxDynamicSharedMemorySize, LDS_BYTES) != hipSuccess) { fprintf(stderr, "kernel_launch: hipFuncSetAttribute failed\n"); grid = -1; return; }
        if (hipOccupancyMaxActiveBlocksPerMultiprocessor(&per_cu, (const void*)hybrid_fwd, 512, LDS_BYTES) != hipSuccess || per_cu < 1) { fprintf(stderr, "kernel_launch: occupancy query says %d\n", per_cu); per_cu = 1; }
        (void)hipGetLastError();
        grid = cus * 1;
        if (grid < 64) { fprintf(stderr, "kernel_launch: grid %d too small\n", grid); grid = -1; return; }
    }
    if (grid < 0) return;
    Args a{};
    a.x = (const float*)d_in[0]; a.pos = (const int*)d_in[1]; a.w_in = (const float*)d_in[2]; a.w_a2 = (const float*)d_in[3]; a.b_a = (const float*)d_in[4]; a.conv_w = (const float*)d_in[5];
    a.a_log = (const float*)d_in[6]; a.dt_bias = (const float*)d_in[7]; a.ret_g = (const float*)d_in[8]; a.gla_g = (const float*)d_in[9]; a.dn_g = (const float*)d_in[10];
    a.w_out = (const float*)d_in[11]; a.ln_g = (const float*)d_in[12]; a.ln_b = (const float*)d_in[13];
    a.out = (float*)d_out; a.ws = (unsigned char*)d_ws; a.ph_lo = 0; a.ph_hi = NPHASE;
    if (hipMemsetAsync((unsigned char*)d_ws + WS_BAR, 0, 16384, stream) != hipSuccess) { fprintf(stderr, "kernel_launch: memset of the barrier words failed\n"); return; }
    void* args[] = {&a};
    hipError_t e = hipLaunchCooperativeKernel((const void*)hybrid_fwd, dim3(grid), dim3(512), args, LDS_BYTES, stream);
    if (e != hipSuccess) fprintf(stderr, "kernel_launch: cooperative launch failed: %s (grid %d)\n", hipGetErrorString(e), grid);
}
```
